# Optimizing an MI355X kernel written in HIP

```python
import math
import jax, jax.numpy as jnp
from jax import lax
import numpy as np


D_MODEL = 1024
BATCH = 16
SEQ = 256
DEPTH = 4
DEC_BATCH = 8
DEC_SEQ = 4096
PAST_LEN = 512

GRID_W = 64
CHUNK = 128
Q_BLOCK = 128
HEAD_DIM = 64
D_A = D_MODEL // 2
SG_GROUP_W = 128
G_A = D_A // SG_GROUP_W
H_B = D_MODEL // 256
D_B = H_B * 2 * HEAD_DIM
H_C = D_MODEL // 128
D_C = H_C * HEAD_DIM
WIN_R = 8
WIN_W = 16
ROPE_THETA = 10000.0
ALPHA = (2 * DEPTH) ** 0.25
BETA = (8 * DEPTH) ** -0.25
EPS = 1e-6
NEG_INF = -1e30
SPLIT_SIZES = (D_A,) * 3 + (D_B,) * 4 + (D_C,) * 4
SPLIT_POINTS = tuple(int(s) for s in np.cumsum(SPLIT_SIZES)[:-1])
D_IN = int(sum(SPLIT_SIZES))

kernel_name = "hybrid_diffusion_gmlp_diffattn_natten_step"


def layernorm(x):
    xf = x.astype(jnp.float32)
    mu = jnp.mean(xf, axis=-1, keepdims=True)
    var = jnp.mean(jnp.square(xf - mu), axis=-1, keepdims=True)
    return ((xf - mu) * lax.rsqrt(var + EPS)).astype(x.dtype)


def modulate(x, mod):
    shift, scale, gate = jnp.split(mod, 3, axis=-1)
    return layernorm(x) * (1 + scale) + shift, gate


def post_norm(x, out, gate, g, b):
    return layernorm(ALPHA * x + gate * out) * g + b


def axial_rope_tables(n_tok):
    t = jnp.arange(n_tok)
    half = HEAD_DIM // 2
    inv = 1.0 / (ROPE_THETA ** (jnp.arange(0, half, 2, dtype=jnp.float32) / half))
    ang_r = (t // GRID_W).astype(jnp.float32)[:, None] * inv
    ang_c = (t % GRID_W).astype(jnp.float32)[:, None] * inv
    ang = jnp.concatenate([ang_r, ang_c], axis=-1)
    return jnp.cos(ang), jnp.sin(ang)


def apply_axial_rope(x, cos, sin):
    L = x.shape[-2]
    quarter = HEAD_DIM // 4
    xr = x.astype(jnp.float32).reshape(*x.shape[:-1], 2, 2, quarter)
    x1, x2 = xr[..., 0, :], xr[..., 1, :]
    c = cos.reshape(L, 2, quarter)
    s = sin.reshape(L, 2, quarter)
    out = jnp.stack([x1 * c - x2 * s, x2 * c + x1 * s], axis=-2)
    return out.reshape(x.shape).astype(x.dtype)


def to_heads(z, n_heads):
    B, L, _ = z.shape
    return z.reshape(B, L, n_heads, -1).transpose(0, 2, 1, 3)


def from_heads(o):
    B, H, L, d = o.shape
    return o.transpose(0, 2, 1, 3).reshape(B, L, H * d)


def diff_heads(zq, zk, zv):
    B, L, _ = zq.shape
    q = zq.reshape(B, L, 2, H_B, HEAD_DIM).transpose(0, 2, 3, 1, 4)
    k = zk.reshape(B, L, 2, H_B, HEAD_DIM).transpose(0, 2, 3, 1, 4)
    v = zv.reshape(B, L, H_B, 2 * HEAD_DIM).transpose(0, 2, 1, 3)
    return q, k, v


def to_blocks(q):
    *lead, L, d = q.shape
    return jnp.moveaxis(q.reshape(*lead, L // Q_BLOCK, Q_BLOCK, d), -3, 0)


def from_blocks(o):
    o = jnp.moveaxis(o, 0, -3)
    return o.reshape(*o.shape[:-3], -1, o.shape[-1])


def chunk_spatial_gate(u, v, g, b, w_s, b_s):
    B, L, _ = v.shape
    vn = layernorm(v) * g + b
    vc = vn.reshape(B, L // CHUNK, CHUNK, G_A, SG_GROUP_W)
    sv = jnp.einsum("gpq,bnqgc->bnpgc", w_s, vc) + b_s.T[None, None, :, :, None]
    return u * sv.reshape(B, L, D_A)


def diff_lambda(lq1, lk1, lq2, lk2, lam_init):
    f = lambda a: a.astype(jnp.float32)
    return jnp.exp(jnp.sum(f(lq1) * f(lk1))) - jnp.exp(jnp.sum(f(lq2) * f(lk2))) + lam_init


def diff_attention(q, k, v, lam):
    scale = HEAD_DIM ** -0.5

    def block(qb):
        s = jnp.einsum("bmhqd,bmhkd->bmhqk", qb, k, preferred_element_type=jnp.float32) * scale
        a = jax.nn.softmax(s, axis=-1)
        w = a[:, 0] - lam * a[:, 1]
        return jnp.einsum("bhqk,bhkd->bhqd", w.astype(v.dtype), v)

    return from_blocks(lax.map(block, to_blocks(q)))


def diff_finish(o, g, lam_init):
    of = o.astype(jnp.float32)
    of = of * lax.rsqrt(jnp.mean(of * of, axis=-1, keepdims=True) + EPS)
    of = of * g.astype(jnp.float32) * (1.0 - lam_init)
    return from_heads(of.astype(o.dtype))


def softmax_attention(q, k, v):
    scale = HEAD_DIM ** -0.5

    def block(qb):
        s = jnp.einsum("bhqd,bhkd->bhqk", qb, k, preferred_element_type=jnp.float32) * scale
        p = jax.nn.softmax(s, axis=-1)
        return jnp.einsum("bhqk,bhkd->bhqd", p.astype(v.dtype), v)

    return from_blocks(lax.map(block, to_blocks(q)))


def neighbourhood_attention(q, k, v, kc, vc, rel_bias):
    B, H, L, d = q.shape
    rows = L // GRID_W
    wr = min(WIN_R, rows)
    scale = d ** -0.5
    qg = q.reshape(B, H, rows, GRID_W, d)
    kg = k.reshape(B, H, rows, GRID_W, d)
    vg = v.reshape(B, H, rows, GRID_W, d)
    cpos = jnp.arange(GRID_W)
    cstart = jnp.clip(cpos - WIN_W // 2, 0, GRID_W - WIN_W)
    colmask = (cpos[None, :] >= cstart[:, None]) & (cpos[None, :] < cstart[:, None] + WIN_W)
    dx_idx = jnp.clip(cpos[None, :] - cpos[:, None], -(WIN_W - 1), WIN_W - 1) + WIN_W - 1

    def row_block(r):
        rs = jnp.clip(r - wr // 2, 0, rows - wr)
        qr = lax.dynamic_index_in_dim(qg, r, axis=2, keepdims=False)
        kb = lax.dynamic_slice_in_dim(kg, rs, wr, axis=2)
        vb = lax.dynamic_slice_in_dim(vg, rs, wr, axis=2)
        dy_idx = rs + jnp.arange(wr) - r + WIN_R - 1
        bias = rel_bias[:, dy_idx[None, :, None], dx_idx[:, None, :]]
        s_loc = jnp.einsum("bhqd,bhjkd->bhqjk", qr, kb, preferred_element_type=jnp.float32) * scale + bias
        s_loc = jnp.where(colmask[:, None, :], s_loc, NEG_INF)
        s_ctx = jnp.einsum("bhqd,bhkd->bhqk", qr, kc, preferred_element_type=jnp.float32) * scale
        n_loc = wr * GRID_W
        s = jnp.concatenate([s_loc.reshape(B, H, GRID_W, n_loc), s_ctx], axis=-1)
        p = jax.nn.softmax(s, axis=-1).astype(v.dtype)
        p_loc = p[..., :n_loc].reshape(B, H, GRID_W, wr, GRID_W)
        p_ctx = p[..., n_loc:]
        return (jnp.einsum("bhqjk,bhjkd->bhqd", p_loc, vb)
                + jnp.einsum("bhqk,bhkd->bhqd", p_ctx, vc))

    out = lax.map(row_block, jnp.arange(rows))
    return jnp.moveaxis(out, 0, 2).reshape(B, H, L, d)


def merge_out(h, y_a, y_b, y_c, w_mg, b_mg, w_a, w_b, w_c, w_o):
    g_a, g_b, g_c = jnp.split(jax.nn.sigmoid(h @ w_mg + b_mg), 3, axis=-1)
    m = g_a * (y_a @ w_a) + g_b * (y_b @ w_b) + g_c * (y_c @ w_c)
    return m @ w_o


def setup_inputs(seed: int = 0) -> dict:
    key = jax.random.key(seed)
    ks = jax.random.split(key, 32)
    nrm = lambda k, shape, s: jax.random.normal(k, shape, jnp.float32) * s
    D = D_MODEL
    return {
        "x_prompt": nrm(ks[0], (BATCH, SEQ, D), 1.0),
        "x_sample": nrm(ks[1], (DEC_BATCH, DEC_SEQ, D), 1.0),
        "c": nrm(ks[2], (DEC_BATCH, D), 1.0),
        "cache_diff_k": nrm(ks[3], (DEC_BATCH, DEPTH, 2, H_B, PAST_LEN, HEAD_DIM), 1.0),
        "cache_diff_v": nrm(ks[4], (DEC_BATCH, DEPTH, H_B, PAST_LEN, 2 * HEAD_DIM), 1.0),
        "cache_na_k": nrm(ks[5], (DEC_BATCH, DEPTH, H_C, PAST_LEN, HEAD_DIM), 1.0),
        "cache_na_v": nrm(ks[6], (DEC_BATCH, DEPTH, H_C, PAST_LEN, HEAD_DIM), 1.0),
        "c_ctx": nrm(ks[7], (D,), 1.0),
        "w_ada": nrm(ks[8], (DEPTH, D, 3 * D), 0.5 * D ** -0.5),
        "b_ada": nrm(ks[9], (DEPTH, 3 * D), 0.02),
        "w_in": nrm(ks[10], (DEPTH, D, D_IN), D ** -0.5),
        "sg_norm_g": 1.0 + nrm(ks[11], (DEPTH, D_A), 0.02),
        "sg_norm_b": nrm(ks[12], (DEPTH, D_A), 0.02),
        "w_spatial": nrm(ks[13], (DEPTH, G_A, CHUNK, CHUNK), CHUNK ** -0.5),
        "b_spatial": 1.0 + nrm(ks[14], (DEPTH, G_A, CHUNK), 0.02),
        "lambda_q1": nrm(ks[15], (DEPTH, HEAD_DIM), 0.1),
        "lambda_k1": nrm(ks[16], (DEPTH, HEAD_DIM), 0.1),
        "lambda_q2": nrm(ks[17], (DEPTH, HEAD_DIM), 0.1),
        "lambda_k2": nrm(ks[18], (DEPTH, HEAD_DIM), 0.1),
        "diff_subln_g": 1.0 + nrm(ks[19], (DEPTH, 2 * HEAD_DIM), 0.02),
        "na_rel_bias": nrm(ks[20], (DEPTH, H_C, 2 * WIN_R - 1, 2 * WIN_W - 1), 0.1),
        "w_br_a": nrm(ks[21], (DEPTH, D_A, D), D_A ** -0.5),
        "w_br_b": nrm(ks[22], (DEPTH, D_B, D), D_B ** -0.5),
        "w_br_c": nrm(ks[23], (DEPTH, D_C, D), D_C ** -0.5),
        "w_mgate": nrm(ks[24], (DEPTH, D, 3 * D), D ** -0.5),
        "b_mgate": nrm(ks[25], (DEPTH, 3 * D), 0.02),
        "w_out": nrm(ks[26], (DEPTH, D, D), BETA * D ** -0.5),
        "ln_g": 1.0 + nrm(ks[27], (DEPTH, D), 0.02),
        "ln_b": nrm(ks[28], (DEPTH, D), 0.02),
    }


def reference(x_prompt, x_sample, c, cache_diff_k, cache_diff_v, cache_na_k, cache_na_v, c_ctx,
              w_ada, b_ada, w_in, sg_norm_g, sg_norm_b, w_spatial, b_spatial,
              lambda_q1, lambda_k1, lambda_q2, lambda_k2, diff_subln_g, na_rel_bias,
              w_br_a, w_br_b, w_br_c, w_mgate, b_mgate, w_out, ln_g, ln_b):
    cos, sin = axial_rope_tables(x_sample.shape[1])
    xp, xs = x_prompt, x_sample
    new_dk, new_dv, new_nk, new_nv = [], [], [], []
    for l in range(DEPTH):
        lam_init = 0.8 - 0.6 * math.exp(-0.3 * l)
        lam = diff_lambda(lambda_q1[l], lambda_k1[l], lambda_q2[l], lambda_k2[l], lam_init)
        merge_w = (w_mgate[l], b_mgate[l], w_br_a[l], w_br_b[l], w_br_c[l], w_out[l])

        h, gate = modulate(xp, jax.nn.silu(c_ctx) @ w_ada[l] + b_ada[l])
        u_a, v_a, g_a, q_b, k_b, v_b, g_b, q_c, k_c, v_c, g_c = jnp.split(h @ w_in[l], SPLIT_POINTS, axis=-1)
        y_a = chunk_spatial_gate(u_a, v_a, sg_norm_g[l], sg_norm_b[l], w_spatial[l], b_spatial[l]) * jax.nn.silu(g_a)
        q, k, v = diff_heads(q_b, k_b, v_b)
        y_b = diff_finish(diff_attention(q, k, v, lam), diff_subln_g[l], lam_init) * jax.nn.silu(g_b)
        qc, kc, vc = to_heads(q_c, H_C), to_heads(k_c, H_C), to_heads(v_c, H_C)
        y_c = from_heads(softmax_attention(qc, kc, vc)) * jax.nn.silu(g_c)
        out = merge_out(h, y_a, y_b, y_c, *merge_w)
        xp = post_norm(xp, out, gate, ln_g[l], ln_b[l])
        new_dk.append(k)
        new_dv.append(v)
        new_nk.append(kc)
        new_nv.append(vc)

        h, gate = modulate(xs, (jax.nn.silu(c) @ w_ada[l] + b_ada[l])[:, None, :])
        u_a, v_a, g_a, q_b, k_b, v_b, g_b, q_c, k_c, v_c, g_c = jnp.split(h @ w_in[l], SPLIT_POINTS, axis=-1)
        y_a = chunk_spatial_gate(u_a, v_a, sg_norm_g[l], sg_norm_b[l], w_spatial[l], b_spatial[l]) * jax.nn.silu(g_a)
        q, k, v = diff_heads(q_b, k_b, v_b)
        q = apply_axial_rope(q, cos, sin)
        k = apply_axial_rope(k, cos, sin)
        k_all = jnp.concatenate([k, cache_diff_k[:, l].astype(k.dtype)], axis=3)
        v_all = jnp.concatenate([v, cache_diff_v[:, l].astype(v.dtype)], axis=2)
        y_b = diff_finish(diff_attention(q, k_all, v_all, lam), diff_subln_g[l], lam_init) * jax.nn.silu(g_b)
        qc, kc, vc = to_heads(q_c, H_C), to_heads(k_c, H_C), to_heads(v_c, H_C)
        y_c = from_heads(neighbourhood_attention(qc, kc, vc, cache_na_k[:, l].astype(kc.dtype),
                                                 cache_na_v[:, l].astype(vc.dtype), na_rel_bias[l])) * jax.nn.silu(g_c)
        out = merge_out(h, y_a, y_b, y_c, *merge_w)
        xs = post_norm(xs, out, gate, ln_g[l], ln_b[l])

    new_diff_k = jnp.stack(new_dk, axis=1)
    new_diff_v = jnp.stack(new_dv, axis=1)
    new_na_k = jnp.stack(new_nk, axis=1)
    new_na_v = jnp.stack(new_nv, axis=1)
    return (xp, xs, new_diff_k, new_diff_v, new_na_k, new_na_v)
```

```cpp
#include <hip/hip_runtime.h>
#include <hip/hip_cooperative_groups.h>
#include <cstdio>
#include <cstdint>
namespace cg = cooperative_groups;

#define DI __device__ __forceinline__
typedef unsigned short bf16_t;
typedef short bf16x8 __attribute__((ext_vector_type(8)));
typedef float f32x16 __attribute__((ext_vector_type(16)));
typedef float f32x4 __attribute__((ext_vector_type(4)));
typedef float f32x2 __attribute__((ext_vector_type(2)));
typedef unsigned u32x4 __attribute__((ext_vector_type(4)));
typedef unsigned u32x2 __attribute__((ext_vector_type(2)));
typedef __bf16 bf2_t __attribute__((ext_vector_type(2)));
typedef _Float16 h2_t __attribute__((ext_vector_type(2)));

#define MFMA(a, b, c) __builtin_amdgcn_mfma_f32_32x32x16_bf16((a), (b), (c), 0, 0, 0)
#define MFMA16(a, b, c) __builtin_amdgcn_mfma_f32_16x16x32_bf16((a), (b), (c), 0, 0, 0)

constexpr int NTHR = 512;
constexpr int D = 1024, NCTX = 4096, NTOK = 36864, DIN = 5632, ZC = 4096, YC = 1536;
constexpr int TG = 20480;
constexpr float ALPHA = 1.6817928305074290f;
constexpr float LOG2E = 1.4426950408889634f;
constexpr float QS = 0.125f * LOG2E;
constexpr float EPS = 1e-6f;
constexpr int SMEM_BYTES = 147456;
constexpr int TEAM_LDS = 53248;
#ifndef ONLY
#define ONLY -1
#endif
#ifndef MIXMASK
#define MIXMASK 31
#endif
#ifndef REPEAT_SUB
#define REPEAT_SUB -1
#endif

struct Params {
  const float *x_prompt, *x_sample, *c, *cache_diff_k, *cache_diff_v, *cache_na_k, *cache_na_v, *c_ctx,
      *w_ada, *b_ada, *w_in, *sg_norm_g, *sg_norm_b, *w_spatial, *b_spatial,
      *lambda_q1, *lambda_k1, *lambda_q2, *lambda_k2, *diff_subln_g, *na_rel_bias,
      *w_br_a, *w_br_b, *w_br_c, *w_mgate, *b_mgate, *w_out, *ln_g, *ln_b;
  float* out;
  bf16_t *WinT, *WmgT, *WaT, *WbT, *WcT, *WoT, *Wsp, *cdk, *cdvT, *cnk, *cnvT, *H, *Z, *Y, *VTa, *VTbL, *VTbC, *VTcL, *VTcC;
  float *mods, *rope, *lam;
  unsigned* bar;
  float lam_init[4];
  int phase_lo, phase_hi;
};

typedef const __attribute__((address_space(4))) Params* PP;
#define p (*pp)
DI PP get_params() { PP k = (PP)__builtin_amdgcn_kernarg_segment_ptr(); asm volatile("" : "+s"(k)); return k; }
DI int tidx() { int t = __builtin_amdgcn_workitem_id_x(); asm volatile("" : "+v"(t)); return t; }
DI unsigned pk2(float a, float b) { f32x2 v = {a, b}; bf2_t r = __builtin_convertvector(v, bf2_t); return __builtin_bit_cast(unsigned, r); }
DI bf16_t f2bf(float a) { return (bf16_t)(pk2(a, 0.f) & 0xffffu); }
DI float bflo(unsigned u) { return __uint_as_float(u << 16); }
DI float bfhi(unsigned u) { return __uint_as_float(u & 0xffff0000u); }
DI float bf2f(bf16_t v) { return __uint_as_float(((unsigned)v) << 16); }
DI int crow(int i, int h) { return (i & 3) + 8 * (i >> 2) + 4 * h; }
DI float fexp2(float x) { return __builtin_amdgcn_exp2f(x); }
DI float silu(float v) { return v * __builtin_amdgcn_rcpf(1.f + __expf(-v)); }
DI float sigmoidf(float v) { return __builtin_amdgcn_rcpf(1.f + __expf(-v)); }
DI int clampi(int v, int lo, int hi) { return v < lo ? lo : (v > hi ? hi : v); }
DI float wave_sum(float v) {
#pragma unroll
  for (int o = 32; o >= 1; o >>= 1) v += __shfl_xor(v, o);
  return v;
}
DI void bar_lds() { asm volatile("s_waitcnt lgkmcnt(0)" ::: "memory"); __builtin_amdgcn_s_barrier(); asm volatile("" ::: "memory"); }
DI void grid_bar(unsigned* ctr, unsigned target) {
  asm volatile("s_waitcnt vmcnt(0)" ::: "memory");
  __syncthreads();
  if (__builtin_amdgcn_workitem_id_x() == 0) {
    __builtin_amdgcn_fence(__ATOMIC_RELEASE, "agent");
    asm volatile("s_waitcnt vmcnt(0)" ::: "memory");
    (void)__hip_atomic_fetch_add(ctr, 1u, __ATOMIC_RELAXED, __HIP_MEMORY_SCOPE_AGENT);
    while (__hip_atomic_load(ctr, __ATOMIC_RELAXED, __HIP_MEMORY_SCOPE_AGENT) < target) __builtin_amdgcn_s_sleep(1);
    __builtin_amdgcn_fence(__ATOMIC_ACQUIRE, "agent");
    asm volatile("s_waitcnt vmcnt(0)" ::: "memory");
  }
  __syncthreads();
}
DI int g_t0(int g) { return g ? TG : 0; }
DI int g_nt(int g) { return g ? (NTOK - TG) : TG; }

DI void transpose_tile(const float* __restrict__ src, int R, int C, bf16_t* __restrict__ dst, int r0, int c0, char* lds) {
  float* tile = (float*)lds;
  const int t = tidx();
  __syncthreads();
#pragma unroll
  for (int i = 0; i < 2; ++i) {
    const int row = (t >> 4) + 32 * i, col = (t & 15) * 4;
    const f32x4 v = *(const f32x4*)(src + (size_t)(r0 + row) * C + c0 + col);
    tile[row * 65 + col + 0] = v.x; tile[row * 65 + col + 1] = v.y; tile[row * 65 + col + 2] = v.z; tile[row * 65 + col + 3] = v.w;
  }
  __syncthreads();
  const int n = t >> 3, kc = t & 7;
  float f[8];
#pragma unroll
  for (int j = 0; j < 8; ++j) f[j] = tile[(kc * 8 + j) * 65 + n];
  u32x4 w = {pk2(f[0], f[1]), pk2(f[2], f[3]), pk2(f[4], f[5]), pk2(f[6], f[7])};
  *(u32x4*)(dst + (size_t)(c0 + n) * R + r0 + kc * 8) = w;
}
DI void transpose_unit(int u, const float* src, bf16_t* dst, int R, int C, char* lds) {
  const int tc = C >> 6, per = (R >> 6) * tc;
  const int b = u / per, rem = u - b * per;
  const int r0 = (rem / tc) * 64, c0 = (rem % tc) * 64;
  transpose_tile(src + (size_t)b * R * C, R, C, dst + (size_t)b * R * C, r0, c0, lds);
}
DI void transpose_tile_w(const float* __restrict__ src, int R, int C, bf16_t* __restrict__ dst, int r0, int c0, char* lds) {
  float* tile = (float*)lds;
  const int t = tidx();
  __syncthreads();
  f32x4 v[4];
#pragma unroll
  for (int i = 0; i < 4; ++i) { const int idx = t + 512 * i, row = idx >> 5, col = (idx & 31) * 4; v[i] = *(const f32x4*)(src + (size_t)(r0 + row) * C + c0 + col); }
#pragma unroll
  for (int i = 0; i < 4; ++i) {
    const int idx = t + 512 * i, row = idx >> 5, col = (idx & 31) * 4;
    tile[row * 129 + col + 0] = v[i].x; tile[row * 129 + col + 1] = v[i].y; tile[row * 129 + col + 2] = v[i].z; tile[row * 129 + col + 3] = v[i].w;
  }
  __syncthreads();
#pragma unroll
  for (int i = 0; i < 2; ++i) {
    const int idx = t + 512 * i, n = idx >> 3, kc = idx & 7;
    float f[8];
#pragma unroll
    for (int j = 0; j < 8; ++j) f[j] = tile[(kc * 8 + j) * 129 + n];
    u32x4 w = {pk2(f[0], f[1]), pk2(f[2], f[3]), pk2(f[4], f[5]), pk2(f[6], f[7])};
    *(u32x4*)(dst + (size_t)(c0 + n) * R + r0 + kc * 8) = w;
  }
}
DI void transpose_unit_w(int u, const float* src, bf16_t* dst, int R, int C, char* lds) {
  const int tc = C >> 7, per = (R >> 6) * tc;
  const int b = u / per, rem = u - b * per;
  const int r0 = (rem / tc) * 64, c0 = (rem % tc) * 128;
  transpose_tile_w(src + (size_t)b * R * C, R, C, dst + (size_t)b * R * C, r0, c0, lds);
}
DI void conv_unit(const float* __restrict__ src, bf16_t* __restrict__ dst) {
  const int t = tidx();
  const f32x4 a = *(const f32x4*)(src + t * 8), b = *(const f32x4*)(src + t * 8 + 4);
  u32x4 w = {pk2(a.x, a.y), pk2(a.z, a.w), pk2(b.x, b.y), pk2(b.z, b.w)};
  *(u32x4*)(dst + t * 8) = w;
}

DI void mods_unit(PP pp, int u, char* lds) {
  const int l = u / 48, cb = u % 48, t = tidx();
  float* sc = (float*)lds;
  __syncthreads();
  for (int i = t; i < 9 * 1024; i += NTHR) {
    const int j = i >> 10, k = i & 1023;
    const float v = (j == 0) ? p.c_ctx[k] : p.c[(j - 1) * 1024 + k];
    sc[i] = silu(v);
  }
  __syncthreads();
  const int cq = t & 15, kg = t >> 4;
  f32x4 a[9];
#pragma unroll
  for (int j = 0; j < 9; ++j) a[j] = (f32x4){0.f, 0.f, 0.f, 0.f};
  const float* w = p.w_ada + (size_t)l * 1024 * 3072 + cb * 64 + cq * 4;
#pragma unroll 4
  for (int k = kg * 32; k < kg * 32 + 32; ++k) {
    const f32x4 wv = *(const f32x4*)(w + (size_t)k * 3072);
#pragma unroll
    for (int j = 0; j < 9; ++j) a[j] += sc[j * 1024 + k] * wv;
  }
  float* red = sc + 9 * 1024;
#pragma unroll
  for (int j = 0; j < 9; ++j) *(f32x4*)(red + (kg * 9 + j) * 64 + cq * 4) = a[j];
  __syncthreads();
  for (int i = t; i < 9 * 64; i += NTHR) {
    const int j = i >> 6, c2 = i & 63;
    float sm = 0.f;
#pragma unroll 8
    for (int k = 0; k < 32; ++k) sm += red[(k * 9 + j) * 64 + c2];
    p.mods[(size_t)(l * 9 + j) * 3072 + cb * 64 + c2] = sm + p.b_ada[l * 3072 + cb * 64 + c2];
  }
}

DI void phase0(PP pp, char* lds) {
  constexpr int U_MODS = 192, U_ROPE = 1, U_LAM = 1, U_WSP = 64;
  constexpr int U_WIN = 4 * 16 * 44, U_WMG = 4 * 16 * 24, U_WBR = 4 * 8 * 8, U_WO = 4 * 16 * 8;
  constexpr int o_rope = U_MODS, o_lam = o_rope + U_ROPE, o_wsp = o_lam + U_LAM, o_win = o_wsp + U_WSP,
                o_wmg = o_win + U_WIN, o_wa = o_wmg + U_WMG, o_wb = o_wa + U_WBR, o_wc = o_wb + U_WBR, o_wo = o_wc + U_WBR, total = o_wo + U_WO;
  const int t = tidx();
  for (int u = blockIdx.x; u < total; u += gridDim.x) {
    if (u < o_rope) mods_unit(pp, u, lds);
    else if (u < o_lam) {
      for (int i = t; i < 1024; i += NTHR) {
        const int pos = i >> 4, f = i & 15;
        const float inv = exp2f(-(float)f * 0.83048202372184058f);
        const float ang = (float)pos * inv;
        p.rope[i * 2] = __cosf(ang); p.rope[i * 2 + 1] = __sinf(ang);
      }
    } else if (u < o_wsp) {
      if (t < 4) {
        float d1 = 0.f, d2 = 0.f;
        for (int i = 0; i < 64; ++i) { d1 += p.lambda_q1[t * 64 + i] * p.lambda_k1[t * 64 + i]; d2 += p.lambda_q2[t * 64 + i] * p.lambda_k2[t * 64 + i]; }
        p.lam[t] = expf(d1) - expf(d2) + p.lam_init[t];
      }
    } else if (u < o_win) { const int v = u - o_wsp; conv_unit(p.w_spatial + (size_t)v * 4096, p.Wsp + (size_t)v * 4096); }
    else if (u < o_wmg) transpose_unit_w(u - o_win, p.w_in, p.WinT, 1024, DIN, lds);
    else if (u < o_wa) transpose_unit_w(u - o_wmg, p.w_mgate, p.WmgT, 1024, 3072, lds);
    else if (u < o_wb) transpose_unit_w(u - o_wa, p.w_br_a, p.WaT, 512, 1024, lds);
    else if (u < o_wc) transpose_unit_w(u - o_wb, p.w_br_b, p.WbT, 512, 1024, lds);
    else if (u < o_wo) transpose_unit_w(u - o_wc, p.w_br_c, p.WcT, 512, 1024, lds);
    else transpose_unit_w(u - o_wo, p.w_out, p.WoT, 1024, 1024, lds);
  }
}

DI void ln_phase(PP pp, int l, int tok0, int ntok, int mode) {
  const int lane = tidx() & 63, wid = tidx() >> 6;
  f32x4 gg[4], bb[4], sh[4], sc[4];
#pragma unroll
  for (int k = 0; k < 4; ++k) {
    gg[k] = bb[k] = sh[k] = sc[k] = (f32x4){0.f, 0.f, 0.f, 0.f};
    if (mode == 1) { gg[k] = *(const f32x4*)(p.ln_g + l * D + k * 256 + lane * 4); bb[k] = *(const f32x4*)(p.ln_b + l * D + k * 256 + lane * 4); }
  }
  const int ln = (mode == 0) ? 0 : l + 1;
  int cur_cid = -1;
  for (int u = blockIdx.x; u * 8 < ntok; u += gridDim.x) {
    const int tk = tok0 + u * 8 + wid;
    const int cid = tk < NCTX ? 0 : 1 + ((tk - NCTX) >> 12);
    float* xs = p.out + (size_t)tk * D;
    const float* xin = (mode == 0) ? (tk < NCTX ? p.x_prompt + (size_t)tk * D : p.x_sample + (size_t)(tk - NCTX) * D) : xs;
    f32x4 v[4];
#pragma unroll
    for (int k = 0; k < 4; ++k) v[k] = *(const f32x4*)(xin + k * 256 + lane * 4);
    if (cid != cur_cid && !(mode == 1 && l == 3)) {
      const float* md = p.mods + (size_t)(ln * 9 + cid) * 3072;
#pragma unroll
      for (int k = 0; k < 4; ++k) { sh[k] = *(const f32x4*)(md + k * 256 + lane * 4); sc[k] = *(const f32x4*)(md + 1024 + k * 256 + lane * 4); }
      cur_cid = cid;
    }
    if (mode == 1) {
      float s = 0.f;
#pragma unroll
      for (int k = 0; k < 4; ++k) s += (v[k].x + v[k].y) + (v[k].z + v[k].w);
      const float mu = wave_sum(s) * (1.f / 1024.f);
      float q = 0.f;
#pragma unroll
      for (int k = 0; k < 4; ++k) { v[k] -= mu; q += (v[k].x * v[k].x + v[k].y * v[k].y) + (v[k].z * v[k].z + v[k].w * v[k].w); }
      const float rstd = rsqrtf(wave_sum(q) * (1.f / 1024.f) + EPS);
#pragma unroll
      for (int k = 0; k < 4; ++k) {
        v[k] = v[k] * rstd * gg[k] + bb[k];
        *(f32x4*)(xs + k * 256 + lane * 4) = v[k];
      }
      if (l == 3) continue;
    }
    float s = 0.f;
#pragma unroll
    for (int k = 0; k < 4; ++k) s += (v[k].x + v[k].y) + (v[k].z + v[k].w);
    const float mu = wave_sum(s) * (1.f / 1024.f);
    float q = 0.f;
#pragma unroll
    for (int k = 0; k < 4; ++k) { v[k] -= mu; q += (v[k].x * v[k].x + v[k].y * v[k].y) + (v[k].z * v[k].z + v[k].w * v[k].w); }
    const float rstd = rsqrtf(wave_sum(q) * (1.f / 1024.f) + EPS);
#pragma unroll
    for (int k = 0; k < 4; ++k) {
      const f32x4 hv = v[k] * rstd * (1.f + sc[k]) + sh[k];
      u32x2 w = {pk2(hv.x, hv.y), pk2(hv.z, hv.w)};
      *(u32x2*)(p.H + (size_t)tk * D + k * 256 + lane * 4) = w;
    }
  }
}

DI int lds_byte(int r, int c) { const int st = (r >> 4) * 2 + (c >> 5), ob = (r & 15) * 64 + (c & 31) * 2; return st * 1024 + (ob ^ (((ob >> 9) & 1) << 5)); }
DI void stage_rc(int b, int& R, int& C) { const int st = b >> 10, sb = b & 1023, swz = sb ^ (((sb >> 9) & 1) << 5); R = (st >> 1) * 16 + swz / 64; C = (st & 1) * 32 + (swz % 64) / 2; }

template <int NT16, int NST>
DI void gemm_pre(const bf16_t* __restrict__ A, int lda, const bf16_t* __restrict__ Bt, int ldb, char* lds) {
  constexpr int TA = 256 * 128, TB = 64 * NT16 * 128, STAGE = TA + TB, GLA = 4, GLB = NT16;
  const int tid = tidx(), lane = tid & 63, wid = tid >> 6;
#pragma unroll
  for (int st = 0; st < NST - 1; ++st) {
#pragma unroll
    for (int i = 0; i < GLA; ++i) { int R, C; stage_rc(wid * 1024 + i * 8192 + lane * 16, R, C);
      __builtin_amdgcn_global_load_lds((const unsigned*)(A + (size_t)R * lda + C + st * 64), (unsigned*)(lds + st * STAGE + wid * 1024 + i * 8192), 16, 0, 0); }
#pragma unroll
    for (int i = 0; i < GLB; ++i) { int R, C; stage_rc(wid * 1024 + i * 8192 + lane * 16, R, C);
      __builtin_amdgcn_global_load_lds((const unsigned*)(Bt + (size_t)R * ldb + C + st * 64), (unsigned*)(lds + st * STAGE + TA + wid * 1024 + i * 8192), 16, 0, 0); }
  }
}
template <int NT16, int NST = 2>
DI void gemm512(const bf16_t* __restrict__ A, int lda, const bf16_t* __restrict__ Bt, int ldb, int K, f32x4 (&acc)[8][NT16], char* lds, bool pre = false) {
  constexpr int TA = 256 * 128, TB = 64 * NT16 * 128, STAGE = TA + TB, GLA = 4, GLB = NT16;
  static_assert(NST * STAGE <= SMEM_BYTES, "LDS ring too large");
  const int tid = tidx(), lane = tid & 63, wid = tid >> 6, wr = wid >> 2, wc = wid & 3, fr = lane & 15, fq = lane >> 4;
  unsigned goa[GLA], gob[GLB];
#pragma unroll
  for (int i = 0; i < GLA; ++i) { int R, C; stage_rc(wid * 1024 + i * 8192 + lane * 16, R, C); goa[i] = (unsigned)(R * lda + C); }
#pragma unroll
  for (int i = 0; i < GLB; ++i) { int R, C; stage_rc(wid * 1024 + i * 8192 + lane * 16, R, C); gob[i] = (unsigned)(R * ldb + C); }
  const int nt = K >> 6;
  auto issue = [&](char* st, int k0) {
#pragma unroll
    for (int i = 0; i < GLA; ++i) __builtin_amdgcn_global_load_lds((const unsigned*)(A + goa[i] + k0), (unsigned*)(st + wid * 1024 + i * 8192), 16, 0, 0);
#pragma unroll
    for (int i = 0; i < GLB; ++i) __builtin_amdgcn_global_load_lds((const unsigned*)(Bt + gob[i] + k0), (unsigned*)(st + TA + wid * 1024 + i * 8192), 16, 0, 0);
  };
  constexpr int DM = GLA + GLB, SLOTS = (NST == 2) ? 8 : 16;
  auto step = [&](const char* cur, char* dst, int kd, bool dma) {
#pragma unroll
    for (int ks = 0; ks < 2; ++ks) {
      bf16x8 Bf[NT16];
#pragma unroll
      for (int n = 0; n < NT16; ++n) Bf[n] = *(const bf16x8*)(cur + TA + lds_byte(wc * 16 * NT16 + n * 16 + fr, ks * 32 + fq * 8));
#pragma unroll
      for (int mh = 0; mh < 2; ++mh) {
      bf16x8 At[4];
#pragma unroll
      for (int m4 = 0; m4 < 4; ++m4) At[m4] = *(const bf16x8*)(cur + lds_byte(wr * 128 + (mh * 4 + m4) * 16 + fr, ks * 32 + fq * 8));
#pragma unroll
      for (int m4 = 0; m4 < 4; ++m4) {
        const int m = mh * 4 + m4;
#pragma unroll
        for (int n = 0; n < NT16; ++n) acc[m][n] = MFMA16(At[m4], Bf[n], acc[m][n]);
        const int q = ks * 8 + m;
#pragma unroll
        for (int j = 0; j < DM; ++j) {
          if (((2 * j + 1) * SLOTS) / (2 * DM) == q) {
            __builtin_amdgcn_sched_barrier(0);
            if (dma) {
              if (j < 2 * GLB) {
                if (j & 1) __builtin_amdgcn_global_load_lds((const unsigned*)(Bt + gob[j >> 1] + kd), (unsigned*)(dst + TA + wid * 1024 + (j >> 1) * 8192), 16, 0, 0);
                else __builtin_amdgcn_global_load_lds((const unsigned*)(A + goa[j >> 1] + kd), (unsigned*)(dst + wid * 1024 + (j >> 1) * 8192), 16, 0, 0);
              } else {
                __builtin_amdgcn_global_load_lds((const unsigned*)(A + goa[j - GLB] + kd), (unsigned*)(dst + wid * 1024 + (j - GLB) * 8192), 16, 0, 0);
              }
            }
            __builtin_amdgcn_sched_barrier(0);
          }
        }
      }
      }
    }
  };
  if (!pre) __syncthreads();
  if (NST == 2) {
    if (!pre) issue(lds, 0);
    asm volatile("s_waitcnt vmcnt(0)" ::: "memory");
    __syncthreads();
#pragma unroll 1
    for (int t = 0; t < nt; ++t) {
      char* cur = lds + (t & 1) * STAGE;
      char* nxt = lds + ((t & 1) ^ 1) * STAGE;
      step(cur, nxt, (t + 1) * 64, t + 1 < nt);
      asm volatile("s_waitcnt vmcnt(0)" ::: "memory");
      __syncthreads();
    }
  } else {
    if (!pre) { issue(lds, 0); issue(lds + STAGE, 64); }
    asm volatile("s_waitcnt vmcnt(%0)" ::"n"(GLA + GLB) : "memory");
    bar_lds();
    int c0 = 0;
#pragma unroll 1
    for (int t = 0; t < nt; ++t) {
      const int c1 = (c0 == 2) ? 0 : c0 + 1, c2 = (c1 == 2) ? 0 : c1 + 1;
      step(lds + c0 * STAGE, lds + c2 * STAGE, (t + 2) * 64, t + 2 < nt);
      if (t + 2 < nt) asm volatile("s_waitcnt vmcnt(%0)" ::"n"(GLA + GLB) : "memory");
      else asm volatile("s_waitcnt vmcnt(0)" ::: "memory");
      bar_lds();
      c0 = c1;
    }
  }
}
template <int NT16>
DI void zero_acc(f32x4 (&acc)[8][NT16]) {
#pragma unroll
  for (int m = 0; m < 8; ++m)
#pragma unroll
    for (int n = 0; n < NT16; ++n) acc[m][n] = (f32x4){0.f, 0.f, 0.f, 0.f};
}
DI int swz(int u, int total) {
  const int G = gridDim.x, b = blockIdx.x, base = u - b;
  return (base + G <= total && (G & 7) == 0) ? base + (b & 7) * (G >> 3) + (b >> 3) : u;
}
DI void tile_order(int t, int ntm, int ntn, int& tm, int& tn) {
  const int per = 8 * ntn, gi = t / per, fm = gi * 8, gsz = (ntm - fm) < 8 ? (ntm - fm) : 8, rem = t - gi * per;
  tm = fm + rem % gsz; tn = rem / gsz;
}

DI void store_f32_staged(const f32x4 (&acc)[8][4], float* o0, int ldo, int lane, char* ldsw) {
  float* st = (float*)ldsw;
  const int fr = lane & 15, fq = lane >> 4;
#pragma unroll
  for (int q = 0; q < 4; ++q) {
#pragma unroll
    for (int mm = 0; mm < 2; ++mm)
#pragma unroll
      for (int n = 0; n < 4; ++n)
#pragma unroll
        for (int jj = 0; jj < 4; ++jj) st[(mm * 16 + fq * 4 + jj) * 68 + n * 16 + fr] = acc[2 * q + mm][n][jj];
    asm volatile("s_waitcnt lgkmcnt(0)" ::: "memory");
#pragma unroll
    for (int i = 0; i < 8; ++i) {
      const int id = lane + 64 * i, rowl = id >> 4, ch = id & 15;
      const f32x4 v = *(const f32x4*)(st + rowl * 68 + ch * 4);
      *(f32x4*)(o0 + (size_t)(q * 32 + rowl) * ldo + ch * 4) = v;
    }
    asm volatile("s_waitcnt lgkmcnt(0)" ::: "memory");
  }
}
DI void epi_in(PP pp, int l, int g, const f32x4 (&acc)[8][4], int lrow0, int col0, int lane, char* lds) {
  const int fr = lane & 15, fq = lane >> 4;
  const int gtok0 = g_t0(g) + lrow0;
  const bool ctx = gtok0 < NCTX;
  const int j = col0 >> 9, cb = col0 & 511;
  int b, pos0;
  if (ctx) { b = gtok0 >> 8; pos0 = gtok0 & 255; } else { b = (gtok0 - NCTX) >> 12; pos0 = (gtok0 - NCTX) & 4095; }
  const int lb = b & 3;
  bf16_t* zrow = p.Z + (size_t)lrow0 * ZC;
  if (j != 1 && j != 5 && j != 9) {
    const int zcb = (j == 0 ? 0 : j == 2 ? 512 : j == 3 ? 1024 : j == 4 ? 1536 : j == 6 ? 2048 : j == 7 ? 2560 : j == 8 ? 3072 : 3584) + cb;
    const bool act = (j == 2 || j == 6 || j == 10), rope = (!ctx) && (j == 3 || j == 4);
    const float qs = (j == 3 || j == 7) ? QS : 1.f;
    bf16_t* st = (bf16_t*)(lds + (tidx() >> 6) * 9216);
    const float* ropel = (const float*)(lds + 73728);
#pragma unroll
    for (int half = 0; half < 2; ++half) {
#pragma unroll
      for (int mm = 0; mm < 4; ++mm) {
        const int m = half * 4 + mm;
        if (rope) {
#pragma unroll
          for (int jj = 0; jj < 4; ++jj) {
            const int pos = pos0 + m * 16 + fq * 4 + jj;
            const f32x2 cr = *(const f32x2*)(ropel + ((pos >> 6) * 16 + fr) * 2), cc = *(const f32x2*)(ropel + ((pos & 63) * 16 + fr) * 2);
            const float x1 = acc[m][0][jj], x2 = acc[m][1][jj], y1 = acc[m][2][jj], y2 = acc[m][3][jj];
            bf16_t* zp = st + (mm * 16 + fq * 4 + jj) * 72 + fr;
            zp[0] = f2bf((x1 * cr.x - x2 * cr.y) * qs); zp[16] = f2bf((x2 * cr.x + x1 * cr.y) * qs);
            zp[32] = f2bf((y1 * cc.x - y2 * cc.y) * qs); zp[48] = f2bf((y2 * cc.x + y1 * cc.y) * qs);
          }
        } else {
#pragma unroll
          for (int n = 0; n < 4; ++n)
#pragma unroll
            for (int jj = 0; jj < 4; ++jj) {
              const float a = acc[m][n][jj];
              st[(mm * 16 + fq * 4 + jj) * 72 + n * 16 + fr] = f2bf(act ? silu(a) : a * qs);
            }
        }
      }
      asm volatile("s_waitcnt lgkmcnt(0)" ::: "memory");
#pragma unroll
      for (int i = 0; i < 8; ++i) {
        const int rowl = i * 8 + (lane >> 3), ch = lane & 7;
        const u32x4 w = *(const u32x4*)(st + rowl * 72 + ch * 8);
        *(u32x4*)(zrow + (size_t)(half * 64 + rowl) * ZC + zcb + ch * 8) = w;
      }
      asm volatile("s_waitcnt lgkmcnt(0)" ::: "memory");
    }
    if (ctx && (j == 4 || j == 8)) {
      float* o;
      if (j == 4) { const int mm = cb >> 8, hh = (cb >> 6) & 3; o = p.out + (size_t)NTOK * D + ((((size_t)(b * 4 + l) * 2 + mm) * 4 + hh) * 256 + pos0) * 64 + fr; }
      else { const int hh = cb >> 6; o = p.out + (size_t)NTOK * D + 2 * (size_t)8388608 + (((size_t)(b * 4 + l) * 8 + hh) * 256 + pos0) * 64 + fr; }
      store_f32_staged(acc, o - fr, 64, lane, lds + (tidx() >> 6) * 9216);
    }
  } else {
    bf16_t* vt; int ld;
    if (j == 1) { vt = p.VTa + ((size_t)(lrow0 >> 7) * 512 + cb) * 128 + (lrow0 & 127); ld = 128; }
    else if (j == 5) {
      const int hh = cb >> 7, dv0 = cb & 127;
      if (ctx) { vt = p.VTbC + ((size_t)(b * 4 + hh) * 128 + dv0) * 256 + pos0; ld = 256; } else { vt = p.VTbL + ((size_t)(lb * 4 + hh) * 128 + dv0) * 4096 + pos0; ld = 4096; }
    } else {
      const int hh = cb >> 6;
      if (ctx) { vt = p.VTcC + ((size_t)(b * 8 + hh) * 64) * 256 + pos0; ld = 256; } else { vt = p.VTcL + ((size_t)(lb * 8 + hh) * 64) * 4096 + pos0; ld = 4096; }
    }
    {
      bf16_t* st = (bf16_t*)(lds + (tidx() >> 6) * 9216);
#pragma unroll
      for (int half = 0; half < 2; ++half) {
#pragma unroll
        for (int mm = 0; mm < 4; ++mm)
#pragma unroll
          for (int n = 0; n < 4; ++n) {
            const int m = half * 4 + mm;
            u32x2 w = {pk2(acc[m][n][0], acc[m][n][1]), pk2(acc[m][n][2], acc[m][n][3])};
            *(u32x2*)(st + (n * 16 + fr) * 68 + mm * 16 + fq * 4) = w;
          }
        asm volatile("s_waitcnt lgkmcnt(0)" ::: "memory");
#pragma unroll
        for (int i = 0; i < 8; ++i) {
          const int id = lane + 64 * i, dvr = id >> 3, ch = id & 7;
          const u32x2 wa = *(const u32x2*)(st + dvr * 68 + ch * 8), wb = *(const u32x2*)(st + dvr * 68 + ch * 8 + 4);
          u32x4 w = {wa.x, wa.y, wb.x, wb.y};
          *(u32x4*)(vt + (size_t)dvr * ld + half * 64 + ch * 8) = w;
        }
        asm volatile("s_waitcnt lgkmcnt(0)" ::: "memory");
      }
    }
    if (ctx && j != 1) {
      float* o;
      if (j == 5) { const int hh = cb >> 7, dv0 = cb & 127; o = p.out + (size_t)NTOK * D + (size_t)8388608 + (((size_t)(b * 4 + l) * 4 + hh) * 256 + pos0) * 128 + dv0 + fr; }
      else { const int hh = cb >> 6; o = p.out + (size_t)NTOK * D + 3 * (size_t)8388608 + (((size_t)(b * 4 + l) * 8 + hh) * 256 + pos0) * 64 + fr; }
      const int ldo = (j == 5) ? 128 : 64;
      store_f32_staged(acc, o - fr, ldo, lane, lds + (tidx() >> 6) * 9216);
    }
  }
}

DI void phase_in(PP pp, int l, int g, char* lds) {
  const int ntm = g_nt(g) / 256, ntn = DIN / 256, ntiles = ntm * ntn;
  constexpr int U_CONV = 256 + 256 + 256 + 256;
  const int rex = ntiles % (int)gridDim.x, nlight = (int)gridDim.x - rex;
  const bool lightonly = rex > 0 && nlight * 4 >= (int)gridDim.x;
  const int cu0 = lightonly ? (int)blockIdx.x - rex : (int)blockIdx.x, cstep = lightonly ? nlight : (int)gridDim.x;
  for (int u = (cu0 < 0 ? U_CONV : cu0); u < U_CONV; u += cstep) {
    if (u < 256) {
      const int b = 4 * g + (u >> 6); const size_t off = (size_t)(u & 63) * 4096;
      conv_unit(p.cache_diff_k + (size_t)(b * 4 + l) * 262144 + off, p.cdk + (size_t)b * 262144 + off);
    } else if (u < 512) {
      const int v = u - 256, b = 4 * g + (v >> 6); const size_t off = (size_t)(v & 63) * 4096;
      conv_unit(p.cache_na_k + (size_t)(b * 4 + l) * 262144 + off, p.cnk + (size_t)b * 262144 + off);
    } else if (u < 768) {
      const int v = u - 512, b = 4 * g + (v >> 6), hh = (v >> 4) & 3, tl = v & 15;
      transpose_tile(p.cache_diff_v + (size_t)((b * 4 + l) * 4 + hh) * 65536, 512, 128, p.cdvT + (size_t)(b * 4 + hh) * 65536, (tl >> 1) * 64, (tl & 1) * 64, lds);
    } else {
      const int v = u - 768, b = 4 * g + (v >> 6), hh = (v >> 3) & 7, tl = v & 7;
      transpose_tile(p.cache_na_v + (size_t)((b * 4 + l) * 8 + hh) * 32768, 512, 64, p.cnvT + (size_t)(b * 8 + hh) * 32768, tl * 64, 0, lds);
    }
  }
  const int lane = tidx() & 63, wid = tidx() >> 6, wr = wid >> 2, wc = wid & 3;
  __syncthreads();
  *(f32x4*)(lds + 139264 + tidx() * 16) = *(const f32x4*)(p.rope + tidx() * 4);
  __syncthreads();
  bool pre = false;
#pragma unroll 1
  for (int u = blockIdx.x; u < ntiles; u += gridDim.x) {
    int tm, tn; tile_order(swz(u, ntiles), ntm, ntn, tm, tn);
    const int row0 = tm * 256, col0 = tn * 256;
    f32x4 acc[8][4]; zero_acc<4>(acc);
    gemm512<4>(p.H + (size_t)(g_t0(g) + row0) * D, D, p.WinT + ((size_t)l * DIN + col0) * D, D, D, acc, lds, pre);
    pre = false;
    if (u + (int)gridDim.x < ntiles) {
      int tm2, tn2; tile_order(swz(u + gridDim.x, ntiles), ntm, ntn, tm2, tn2);
      gemm_pre<4, 2>(p.H + (size_t)(g_t0(g) + tm2 * 256) * D, D, p.WinT + ((size_t)l * DIN + tn2 * 256) * D, D, lds);
      pre = true;
    }
    epi_in(pp, l, g, acc, row0 + wr * 128, col0 + wc * 64, lane, lds + 65536);
  }
}

struct KVSeg { const bf16_t* K; const bf16_t* VT; int ldk, ldvt, nblk; };

template <int DVT, int MODE, int TEAM>
DI void attn_pass(const bf16_t* __restrict__ Qw, const KVSeg& s0, const KVSeg& s1, f32x16 (&O)[DVT], float& lsum,
                  int na_qrow, int na_qcol, int na_R0, const float* relb, char* lds) {
  constexpr int STG = 9216 + DVT * 32 * 144;
  constexpr int KCH = 512 / TEAM, VCH = DVT * 256 / TEAM;
  const int tt = tidx() & (TEAM - 1), lane = tt & 63, h = lane >> 5, r = lane & 31;
  bf16x8 qf[4];
#pragma unroll
  for (int s = 0; s < 4; ++s) qf[s] = *(const bf16x8*)(Qw + s * 16 + h * 8);
#pragma unroll
  for (int dt = 0; dt < DVT; ++dt)
#pragma unroll
    for (int i = 0; i < 16; ++i) O[dt][i] = 0.f;
  float m = 0.f, l = 0.f;
  f32x16 negm;
#pragma unroll
  for (int i = 0; i < 16; ++i) negm[i] = 0.f;
  u32x4 kr0[KCH], vr0[VCH], kr1[KCH], vr1[VCH];
  const int nblk = s0.nblk + s1.nblk;
  const int lrow = tt >> 3, lkc = tt & 7;
  auto gload = [&](int j, u32x4 (&kreg)[KCH], u32x4 (&vreg)[VCH]) {
    const bool first = j < s0.nblk;
    const bf16_t* Kp = first ? s0.K : s1.K; const bf16_t* Vp = first ? s0.VT : s1.VT;
    const int ldk = first ? s0.ldk : s1.ldk, ldvt = first ? s0.ldvt : s1.ldvt;
    const int key0 = (first ? j : j - s0.nblk) * 64;
#pragma unroll
    for (int i = 0; i < KCH; ++i) kreg[i] = *(const u32x4*)(Kp + (size_t)(key0 + lrow + (TEAM / 8) * i) * ldk + lkc * 8);
#pragma unroll
    for (int i = 0; i < VCH; ++i) vreg[i] = *(const u32x4*)(Vp + (size_t)(lrow + (TEAM / 8) * i) * ldvt + key0 + lkc * 8);
  };
  auto lstore = [&](int buf, const u32x4 (&kreg)[KCH], const u32x4 (&vreg)[VCH]) {
    bf16_t* Ks = (bf16_t*)(lds + buf * STG);
    bf16_t* VTs = (bf16_t*)(lds + buf * STG + 9216);
#pragma unroll
    for (int i = 0; i < KCH; ++i) *(u32x4*)(Ks + (lrow + (TEAM / 8) * i) * 72 + lkc * 8) = kreg[i];
#pragma unroll
    for (int i = 0; i < VCH; ++i) {
      bf16_t* d = VTs + (lrow + (TEAM / 8) * i) * 72 + (lkc >> 1) * 16 + (lkc & 1) * 4;
      u32x2 lo = {vreg[i].x, vreg[i].y}, hi = {vreg[i].z, vreg[i].w};
      *(u32x2*)d = lo; *(u32x2*)(d + 8) = hi;
    }
  };
  gload(0, kr0, vr0);
  if (nblk > 1) gload(1, kr1, vr1);
  __syncthreads();
  lstore(0, kr0, vr0);
  if (nblk > 2) gload(2, kr0, vr0);
#pragma unroll 1
  for (int j = 0; j < nblk; ++j) {
    bar_lds();
    if (j + 1 < nblk) {
      if (j & 1) { lstore(0, kr0, vr0); if (j + 3 < nblk) gload(j + 3, kr0, vr0); }
      else { lstore(1, kr1, vr1); if (j + 3 < nblk) gload(j + 3, kr1, vr1); }
    }
    const bf16_t* Ks = (const bf16_t*)(lds + (j & 1) * STG);
    const bf16_t* VTs = (const bf16_t*)(lds + (j & 1) * STG + 9216);
    const bool local = (MODE == 1) && (j >= s0.nblk);
    int krow = 0; bool active = true;
    if (local) { krow = na_R0 + (j - s0.nblk); const int rs = clampi(na_qrow - 4, 0, 56); active = (krow >= rs) && (krow < rs + 8); }
    if (active) {
      f32x16 S[2];
#pragma unroll
      for (int kt = 0; kt < 2; ++kt) {
        bf16x8 kf[4];
#pragma unroll
        for (int s = 0; s < 4; ++s) kf[s] = *(const bf16x8*)(Ks + (kt * 32 + r) * 72 + s * 16 + h * 8);
        S[kt] = MFMA(kf[0], qf[0], negm);
#pragma unroll
        for (int s = 1; s < 4; ++s) S[kt] = MFMA(kf[s], qf[s], S[kt]);
      }
      if (local) {
        const int dy = krow - na_qrow + 7, cs = clampi(na_qcol - 8, 0, 48);
        const int tcs = 4 * h - cs;
        const float* rb = relb + (dy * 31 + 4 * h - na_qcol + 15 + 48);
#pragma unroll
        for (int kt = 0; kt < 2; ++kt)
#pragma unroll
          for (int i = 0; i < 16; ++i) {
            const int c0 = kt * 32 + (i & 3) + 8 * (i >> 2);
            const bool ok = (unsigned)(c0 + tcs) < 16u;
            S[kt][i] = ok ? S[kt][i] + rb[c0] : -1e30f;
          }
      }
      float mx = S[0][0];
#pragma unroll
      for (int kt = 0; kt < 2; ++kt)
#pragma unroll
        for (int i = 0; i < 16; ++i) mx = fmaxf(mx, S[kt][i]);
      mx = fmaxf(mx, __shfl_xor(mx, 32));
      if (j == 0 || __builtin_amdgcn_ballot_w64(mx > 8.f) != 0ull) {
        const float delta = (j == 0) ? mx : fmaxf(mx, 0.f), alpha = fexp2(-delta);
        m += delta;
#pragma unroll
        for (int i = 0; i < 16; ++i) negm[i] = -m;
#pragma unroll
        for (int kt = 0; kt < 2; ++kt)
#pragma unroll
          for (int i = 0; i < 16; ++i) S[kt][i] -= delta;
        l *= alpha;
#pragma unroll
        for (int dt = 0; dt < DVT; ++dt) O[dt] *= alpha;
      }
      float ps = 0.f;
#pragma unroll
      for (int kt = 0; kt < 2; ++kt)
#pragma unroll
        for (int i = 0; i < 16; ++i) { const float p0 = fexp2(S[kt][i]); S[kt][i] = p0; ps += p0; }
      l += ps;
#pragma unroll
      for (int kt = 0; kt < 2; ++kt)
#pragma unroll
        for (int sp = 0; sp < 2; ++sp) {
          u32x4 pw = {pk2(S[kt][8 * sp + 0], S[kt][8 * sp + 1]), pk2(S[kt][8 * sp + 2], S[kt][8 * sp + 3]),
                      pk2(S[kt][8 * sp + 4], S[kt][8 * sp + 5]), pk2(S[kt][8 * sp + 6], S[kt][8 * sp + 7])};
          const bf16x8 pf = __builtin_bit_cast(bf16x8, pw);
#pragma unroll
          for (int dt = 0; dt < DVT; ++dt) {
            const u32x4 vw = *(const u32x4*)(VTs + (dt * 32 + r) * 72 + kt * 32 + sp * 16 + h * 8);
            O[dt] = MFMA(__builtin_bit_cast(bf16x8, vw), pf, O[dt]);
          }
        }
    }
  }
  l += __shfl_xor(l, 32);
  lsum = l;
}

DI void diff_tile(PP pp, int l, int lrow0, int krow0, int own_blk, int hh, const bf16_t* VTown, int ldvt_own,
                  const bf16_t* cK  , const bf16_t* cVT  , char* lds) {
  constexpr int STG = 2 * 9216 + 128 * 144;
  const int tid = tidx(), lane = tid & 63, wid = tid >> 6, h = lane >> 5, r = lane & 31, qs = wid & 3, mm = wid >> 2;
  const int row = lrow0 + qs * 32 + r;
  const bf16_t* Qw = p.Z + (size_t)row * ZC + 1024 + mm * 256 + hh * 64;
  const bf16_t* K0 = p.Z + (size_t)krow0 * ZC + 1536 + hh * 64;
  const bf16_t* K1 = cK ? cK + (size_t)hh * 32768 : K0;
  const int nblk = own_blk + (cK ? 8 : 0);
  bf16x8 qf[4];
#pragma unroll
  for (int s = 0; s < 4; ++s) qf[s] = *(const bf16x8*)(Qw + s * 16 + h * 8);
  f32x16 O[4];
#pragma unroll
  for (int dt = 0; dt < 4; ++dt)
#pragma unroll
    for (int i = 0; i < 16; ++i) O[dt][i] = 0.f;
  float m = 0.f;
  f32x16 negm;
  float lacc = 0.f;
#pragma unroll
  for (int i = 0; i < 16; ++i) negm[i] = 0.f;
  u32x4 kA[2], vA[2], kB[2], vB[2];
  const int lrow = tid >> 3, lkc = tid & 7;
  const bf16_t* kbase = K0 + (size_t)lrow * ZC + lkc * 8;
  const bf16_t* vbase = VTown + (size_t)lrow * ldvt_own + lkc * 8;
  const bf16_t* ckbase = K1 + (size_t)lrow * 64 + lkc * 8;
  const bf16_t* cvbase = (cK ? cVT : VTown) + (size_t)lrow * 512 + lkc * 8;
  const size_t vrow64 = (size_t)64 * ldvt_own;
  auto gload = [&](int j, u32x4 (&kreg)[2], u32x4 (&vreg)[2]) {
    if (j < own_blk) {
      const size_t ko = (size_t)j * (64 * ZC);
      kreg[0] = *(const u32x4*)(kbase + ko);
      kreg[1] = *(const u32x4*)(kbase + ko + 256);
      vreg[0] = *(const u32x4*)(vbase + j * 64);
      vreg[1] = *(const u32x4*)(vbase + vrow64 + j * 64);
    } else {
      const int jj = j - own_blk;
      kreg[0] = *(const u32x4*)(ckbase + jj * 4096);
      kreg[1] = *(const u32x4*)(ckbase + jj * 4096 + 4 * 32768);
      vreg[0] = *(const u32x4*)(cvbase + jj * 64);
      vreg[1] = *(const u32x4*)(cvbase + 64 * 512 + jj * 64);
    }
  };
  auto lstore = [&](int buf, const u32x4 (&kreg)[2], const u32x4 (&vreg)[2]) {
    bf16_t* Ks = (bf16_t*)(lds + buf * STG);
    bf16_t* VTs = (bf16_t*)(lds + buf * STG + 2 * 9216);
    *(u32x4*)(Ks + lrow * 72 + lkc * 8) = kreg[0];
    *(u32x4*)(Ks + 4608 + lrow * 72 + lkc * 8) = kreg[1];
#pragma unroll
    for (int i = 0; i < 2; ++i) {
      bf16_t* d = VTs + (lrow + 64 * i) * 72 + (lkc >> 1) * 16 + (lkc & 1) * 4;
      u32x2 lo = {vreg[i].x, vreg[i].y}, hi = {vreg[i].z, vreg[i].w};
      *(u32x2*)d = lo; *(u32x2*)(d + 8) = hi;
    }
  };
  auto body = [&](int j) {
    const bf16_t* Ks = (const bf16_t*)(lds + (j & 1) * STG) + mm * 4608;
    const bf16_t* VTs = (const bf16_t*)(lds + (j & 1) * STG + 2 * 9216);
    f32x16 S[2];
#pragma unroll
    for (int kt = 0; kt < 2; ++kt) {
      bf16x8 kf[4];
#pragma unroll
      for (int s = 0; s < 4; ++s) kf[s] = *(const bf16x8*)(Ks + (kt * 32 + r) * 72 + s * 16 + h * 8);
      S[kt] = MFMA(kf[0], qf[0], negm);
#pragma unroll
      for (int s = 1; s < 4; ++s) S[kt] = MFMA(kf[s], qf[s], S[kt]);
    }
    if ((j & 1) == 0) {
      float mx = S[0][0];
#pragma unroll
      for (int kt = 0; kt < 2; ++kt)
#pragma unroll
        for (int i = 0; i < 16; ++i) mx = fmaxf(mx, S[kt][i]);
      mx = fmaxf(mx, __shfl_xor(mx, 32));
      if (j == 0 || __builtin_amdgcn_ballot_w64(mx > 8.f) != 0ull) {
        const float delta = (j == 0) ? mx : fmaxf(mx, 0.f), alpha = fexp2(-delta);
        m += delta;
#pragma unroll
        for (int i = 0; i < 16; ++i) negm[i] = -m;
#pragma unroll
        for (int kt = 0; kt < 2; ++kt)
#pragma unroll
          for (int i = 0; i < 16; ++i) S[kt][i] -= delta;
        lacc *= alpha;
#pragma unroll
        for (int dt = 0; dt < 4; ++dt) O[dt] *= alpha;
      }
    }
    float ps = 0.f;
#pragma unroll
    for (int kt = 0; kt < 2; ++kt)
#pragma unroll
      for (int i = 0; i < 16; ++i) { const float p0 = fexp2(S[kt][i]); S[kt][i] = p0; ps += p0; }
    lacc += ps;
#pragma unroll
    for (int kt = 0; kt < 2; ++kt)
#pragma unroll
      for (int sp = 0; sp < 2; ++sp) {
        u32x4 pw = {pk2(S[kt][8 * sp + 0], S[kt][8 * sp + 1]), pk2(S[kt][8 * sp + 2], S[kt][8 * sp + 3]),
                    pk2(S[kt][8 * sp + 4], S[kt][8 * sp + 5]), pk2(S[kt][8 * sp + 6], S[kt][8 * sp + 7])};
        const bf16x8 pf = __builtin_bit_cast(bf16x8, pw);
        u32x4 vw[4];
#pragma unroll
        for (int dt = 0; dt < 4; ++dt) {
          vw[dt] = *(const u32x4*)(VTs + (dt * 32 + r) * 72 + kt * 32 + sp * 16 + h * 8);
        }
#pragma unroll
        for (int dt = 0; dt < 4; ++dt) O[dt] = MFMA(__builtin_bit_cast(bf16x8, vw[dt]), pf, O[dt]);
      }
  };
  gload(0, kA, vA);
  gload(1, kB, vB);
  __syncthreads();
  lstore(0, kA, vA);
  if (nblk > 2) gload(2, kA, vA);
#pragma unroll 1
  for (int j = 0; j < nblk; j += 2) {
    bar_lds();
    lstore(1, kB, vB);
    if (j + 3 < nblk) gload(j + 3, kB, vB);
    body(j);
    bar_lds();
    if (j + 2 < nblk) { lstore(0, kA, vA); if (j + 4 < nblk) gload(j + 4, kA, vA); }
    body(j + 1);
  }
  const float lsum = lacc + __shfl_xor(lacc, 32);
  float* xch = (float*)lds;
  const float scale = (mm == 0) ? 1.f / lsum : p.lam[l] / lsum;
  __syncthreads();
  if (mm == 1) {
#pragma unroll
    for (int dt = 0; dt < 4; ++dt)
#pragma unroll
      for (int i = 0; i < 16; ++i) xch[((qs * 4 + dt) * 16 + i) * 64 + lane] = O[dt][i] * scale;
  }
  __syncthreads();
  if (mm == 0) {
    float ss = 0.f;
#pragma unroll
    for (int dt = 0; dt < 4; ++dt)
#pragma unroll
      for (int i = 0; i < 16; ++i) { const float o = O[dt][i] * scale - xch[((qs * 4 + dt) * 16 + i) * 64 + lane]; O[dt][i] = o; ss += o * o; }
    ss += __shfl_xor(ss, 32);
    const float rr = rsqrtf(ss * (1.f / 128.f) + EPS) * (1.f - p.lam_init[l]);
    bf16_t* Ys = (bf16_t*)(lds + 65536);
#pragma unroll
    for (int dt = 0; dt < 4; ++dt)
#pragma unroll
      for (int gq = 0; gq < 4; ++gq) {
        const int dv0 = dt * 32 + 8 * gq + 4 * h;
        const f32x4 g4 = *(const f32x4*)(p.diff_subln_g + l * 128 + dv0);
        u32x2 w = {pk2(O[dt][4 * gq + 0] * rr * g4.x, O[dt][4 * gq + 1] * rr * g4.y), pk2(O[dt][4 * gq + 2] * rr * g4.z, O[dt][4 * gq + 3] * rr * g4.w)};
        *(u32x2*)(Ys + (qs * 32 + r) * 132 + dv0) = w;
      }
  }
  __syncthreads();
  {
    const bf16_t* Ys = (const bf16_t*)(lds + 65536);
#pragma unroll
    for (int i = 0; i < 4; ++i) {
      const int id = tid + 512 * i, rowl = id >> 4, c8 = (id & 15) * 8;
      const size_t grow = (size_t)(lrow0 + rowl);
      const u32x2 ya = *(const u32x2*)(Ys + rowl * 132 + c8), yb = *(const u32x2*)(Ys + rowl * 132 + c8 + 4);
      const u32x4 s8 = *(const u32x4*)(p.Z + grow * ZC + 2048 + hh * 128 + c8);
      u32x4 y;
      y.x = pk2(bflo(ya.x) * bflo(s8.x), bfhi(ya.x) * bfhi(s8.x));
      y.y = pk2(bflo(ya.y) * bflo(s8.y), bfhi(ya.y) * bfhi(s8.y));
      y.z = pk2(bflo(yb.x) * bflo(s8.z), bfhi(yb.x) * bfhi(s8.z));
      y.w = pk2(bflo(yb.y) * bflo(s8.w), bfhi(yb.y) * bfhi(s8.w));
      *(u32x4*)(p.Y + grow * YC + 512 + hh * 128 + c8) = y;
    }
  }
}

template <int MODE, int TEAM>
DI void c_tile(PP pp, int l, int lrow0, int hh, const KVSeg& s0, const KVSeg& s1, int na_qrow0, int na_R0, char* lds) {
  const int tt = tidx() & (TEAM - 1), lane = tt & 63, wq = tt >> 6, h = lane >> 5, r = lane & 31;
  const int row = lrow0 + wq * 32 + r;
  float* relb = (float*)(lds + 36864);
  if (MODE == 1) {
    __syncthreads();
    {
      const float* rbp = p.na_rel_bias + (size_t)(l * 8 + hh) * 465;
      const int i0 = tt, i1 = tt + TEAM;
      const float v0 = (i0 < 465) ? rbp[i0] : 0.f, v1 = (i1 < 465) ? rbp[i1] : 0.f;
      if (i0 < 465) relb[48 + i0] = v0 * LOG2E;
      if (i1 < 465) relb[48 + i1] = v1 * LOG2E;
    }
  }
  f32x16 O[2];
  float ls;
  attn_pass<2, MODE, TEAM>(p.Z + (size_t)row * ZC + 2560 + hh * 64, s0, s1, O, ls, na_qrow0 + (wq >> 1), (wq & 1) * 32 + r, na_R0, relb, lds);
  const float inv = 1.f / ls;
  __syncthreads();
  bf16_t* Ys = (bf16_t*)lds;
#pragma unroll
  for (int dt = 0; dt < 2; ++dt)
#pragma unroll
    for (int gq = 0; gq < 4; ++gq) {
      const int dv0 = dt * 32 + 8 * gq + 4 * h;
      u32x2 w = {pk2(O[dt][4 * gq + 0] * inv, O[dt][4 * gq + 1] * inv), pk2(O[dt][4 * gq + 2] * inv, O[dt][4 * gq + 3] * inv)};
      *(u32x2*)(Ys + (wq * 32 + r) * 68 + dv0) = w;
    }
  __syncthreads();
#pragma unroll
  for (int i = 0; i < 4; ++i) {
    const int id = tt + TEAM * i, rowl = id >> 3, c8 = (id & 7) * 8;
    const size_t grow = (size_t)(lrow0 + rowl);
    const u32x2 ya = *(const u32x2*)(Ys + rowl * 68 + c8), yb = *(const u32x2*)(Ys + rowl * 68 + c8 + 4);
    const u32x4 s8 = *(const u32x4*)(p.Z + grow * ZC + 3584 + hh * 64 + c8);
    u32x4 y;
    y.x = pk2(bflo(ya.x) * bflo(s8.x), bfhi(ya.x) * bfhi(s8.x));
    y.y = pk2(bflo(ya.y) * bflo(s8.y), bfhi(ya.y) * bfhi(s8.y));
    y.z = pk2(bflo(yb.x) * bflo(s8.z), bfhi(yb.x) * bfhi(s8.z));
    y.w = pk2(bflo(yb.y) * bflo(s8.w), bfhi(yb.y) * bfhi(s8.w));
    *(u32x4*)(p.Y + grow * YC + 1024 + hh * 64 + c8) = y;
  }
}

DI void a_tile(PP pp, int l, int ch, int g, char* lds) {
  const int tid = tidx() & 255, lane = tid & 63, wid = tid >> 6, h = lane >> 5, r = lane & 31;
  float* red = (float*)lds;
  float* stat = (float*)(lds + 16384);
  bf16_t* Bs = (bf16_t*)(lds + 17408);
  const bf16_t* Va = p.VTa + (size_t)ch * 512 * 128;
  __syncthreads();
  {
    const int q8 = (tid & 15) * 8, cgp = tid >> 4;
    float s[8], q[8];
#pragma unroll
    for (int j = 0; j < 8; ++j) { s[j] = 0.f; q[j] = 0.f; }
#pragma unroll
    for (int c0 = cgp * 32; c0 < cgp * 32 + 32; c0 += 16) {
      u32x4 w[16];
#pragma unroll
      for (int k = 0; k < 16; ++k) w[k] = *(const u32x4*)(Va + (size_t)(c0 + k) * 128 + q8);
#pragma unroll
      for (int k = 0; k < 16; ++k) {
        const float f[8] = {bflo(w[k].x), bfhi(w[k].x), bflo(w[k].y), bfhi(w[k].y), bflo(w[k].z), bfhi(w[k].z), bflo(w[k].w), bfhi(w[k].w)};
#pragma unroll
        for (int j = 0; j < 8; ++j) { s[j] += f[j]; q[j] += f[j] * f[j]; }
      }
    }
#pragma unroll
    for (int j = 0; j < 8; ++j) { red[(cgp * 128 + q8 + j) * 2] = s[j]; red[(cgp * 128 + q8 + j) * 2 + 1] = q[j]; }
  }
  __syncthreads();
  if (tid < 128) {
    float s = 0.f, q = 0.f;
#pragma unroll
    for (int k = 0; k < 16; ++k) { s += red[(k * 128 + tid) * 2]; q += red[(k * 128 + tid) * 2 + 1]; }
    const float mu = s * (1.f / 512.f), var = fmaxf(q * (1.f / 512.f) - mu * mu, 0.f);
    stat[tid * 2] = mu; stat[tid * 2 + 1] = rsqrtf(var + EPS);
  }
  __syncthreads();
  {
    u32x4 w[8];
#pragma unroll
    for (int i = 0; i < 8; ++i) { const int id = tid + 256 * i, c = id >> 4, qc = id & 15; w[i] = *(const u32x4*)(Va + (size_t)(g * 128 + c) * 128 + qc * 8); }
#pragma unroll
    for (int i = 0; i < 8; ++i) {
      const int id = tid + 256 * i, c = id >> 4, qc = id & 15;
      const float gam = p.sg_norm_g[l * 512 + g * 128 + c], bet = p.sg_norm_b[l * 512 + g * 128 + c];
      const float f[8] = {bflo(w[i].x), bfhi(w[i].x), bflo(w[i].y), bfhi(w[i].y), bflo(w[i].z), bfhi(w[i].z), bflo(w[i].w), bfhi(w[i].w)};
      float o[8];
#pragma unroll
      for (int j = 0; j < 8; ++j) { const int q = qc * 8 + j; o[j] = (f[j] - stat[q * 2]) * stat[q * 2 + 1] * gam + bet; }
      u32x4 ow = {pk2(o[0], o[1]), pk2(o[2], o[3]), pk2(o[4], o[5]), pk2(o[6], o[7])};
      *(u32x4*)(Bs + c * 136 + qc * 8) = ow;
    }
  }
  __syncthreads();
  f32x16 acc[4];
#pragma unroll
  for (int ct = 0; ct < 4; ++ct)
#pragma unroll
    for (int i = 0; i < 16; ++i) acc[ct][i] = 0.f;
  const bf16_t* W = p.Wsp + (size_t)(l * 4 + g) * 16384 + (size_t)(wid * 32 + r) * 128;
#pragma unroll
  for (int s = 0; s < 8; ++s) {
    const bf16x8 wf = *(const bf16x8*)(W + s * 16 + h * 8);
#pragma unroll
    for (int ct = 0; ct < 4; ++ct) {
      const bf16x8 vf = *(const bf16x8*)(Bs + (ct * 32 + r) * 136 + s * 16 + h * 8);
      acc[ct] = MFMA(vf, wf, acc[ct]);
    }
  }
  const int prw = wid * 32 + r;
  const float bsp = p.b_spatial[(l * 4 + g) * 128 + prw];
  __syncthreads();
  bf16_t* Ss = Bs;
#pragma unroll
  for (int ct = 0; ct < 4; ++ct)
#pragma unroll
    for (int gq = 0; gq < 4; ++gq) {
      u32x2 w = {pk2(acc[ct][4 * gq + 0] + bsp, acc[ct][4 * gq + 1] + bsp), pk2(acc[ct][4 * gq + 2] + bsp, acc[ct][4 * gq + 3] + bsp)};
      *(u32x2*)(Ss + prw * 132 + ct * 32 + 8 * gq + 4 * h) = w;
    }
  __syncthreads();
#pragma unroll
  for (int i = 0; i < 8; ++i) {
    const int id = tid + 256 * i, rowl = id >> 4, c8 = (id & 15) * 8;
    const size_t row = (size_t)ch * 128 + rowl;
    const u32x2 sa = *(const u32x2*)(Ss + rowl * 132 + c8), sb = *(const u32x2*)(Ss + rowl * 132 + c8 + 4);
    const u32x4 u8 = *(const u32x4*)(p.Z + row * ZC + g * 128 + c8), s8 = *(const u32x4*)(p.Z + row * ZC + 512 + g * 128 + c8);
    u32x4 y;
    y.x = pk2(bflo(u8.x) * bflo(sa.x) * bflo(s8.x), bfhi(u8.x) * bfhi(sa.x) * bfhi(s8.x));
    y.y = pk2(bflo(u8.y) * bflo(sa.y) * bflo(s8.y), bfhi(u8.y) * bfhi(sa.y) * bfhi(s8.y));
    y.z = pk2(bflo(u8.z) * bflo(sb.x) * bflo(s8.z), bfhi(u8.z) * bfhi(sb.x) * bfhi(s8.z));
    y.w = pk2(bflo(u8.w) * bflo(sb.y) * bflo(s8.w), bfhi(u8.w) * bfhi(sb.y) * bfhi(s8.w));
    *(u32x4*)(p.Y + row * YC + g * 128 + c8) = y;
  }
}

DI void phase_mix(PP pp0, int l, int g, char* lds, int mask = 31) {
  const int lat0 = g == 0 ? NCTX : 0;
  if (mask & 1) {
    PP pp = get_params();
#pragma unroll 1
    for (int u0 = blockIdx.x; u0 < 512; u0 += gridDim.x) {
      const int u = swz(u0, 512);
      const int lb = u >> 7, hh = (u >> 5) & 3, qb = u & 31, b = 4 * g + lb;
      const int krow0 = lat0 + lb * 4096;
      diff_tile(pp, l, krow0 + qb * 128, krow0, 64, hh, p.VTbL + (size_t)(lb * 4 + hh) * 128 * 4096, 4096,
                p.cdk + (size_t)b * 262144, p.cdvT + (size_t)(b * 4 + hh) * 65536, lds);
    }
  }
  if (mask & 2) {
    PP pp = get_params();
    const int team = tidx() >> 8;
#pragma unroll 1
    for (int u0 = blockIdx.x; u0 < 512; u0 += gridDim.x) {
      const int v = 2 * swz(u0, 512) + team;
      const int lb = v >> 8, hh = (v >> 5) & 7, pr = v & 31, b = 4 * g + lb;
      const int krow0 = lat0 + lb * 4096;
      int R0 = clampi(2 * pr - 4, 0, 56); if (R0 > 55) R0 = 55;
      KVSeg s0, s1;
      s0.K = p.cnk + (size_t)(b * 8 + hh) * 32768; s0.ldk = 64; s0.VT = p.cnvT + (size_t)(b * 8 + hh) * 32768; s0.ldvt = 512; s0.nblk = 8;
      s1.K = p.Z + (size_t)(krow0 + R0 * 64) * ZC + 3072 + hh * 64; s1.ldk = ZC; s1.VT = p.VTcL + (size_t)(lb * 8 + hh) * 64 * 4096 + R0 * 64; s1.ldvt = 4096; s1.nblk = 9;
      c_tile<1, 256>(pp, l, krow0 + pr * 128, hh, s0, s1, 2 * pr, R0, lds + team * TEAM_LDS);
    }
  }
  if (g == 0 && (mask & 4)) {
    PP pp = get_params();
#pragma unroll 1
    for (int v = blockIdx.x; v < 128; v += gridDim.x) {
      const int b = v >> 3, hh = (v >> 1) & 3, qb = v & 1;
      diff_tile(pp, l, b * 256 + qb * 128, b * 256, 4, hh, p.VTbC + (size_t)(b * 4 + hh) * 128 * 256, 256, nullptr, nullptr, lds);
    }
  }
  if (g == 0 && (mask & 8)) {
    PP pp = get_params();
#pragma unroll 1
    for (int v = blockIdx.x; v < 128; v += gridDim.x) {
      const int b = v >> 3, hh = v & 7;
      KVSeg s0, s1;
      s0.K = p.Z + (size_t)(b * 256) * ZC + 3072 + hh * 64; s0.ldk = ZC; s0.VT = p.VTcC + (size_t)(b * 8 + hh) * 64 * 256; s0.ldvt = 256; s0.nblk = 4;
      s1 = s0; s1.nblk = 0;
      c_tile<0, 512>(pp, l, b * 256, hh, s0, s1, 0, 0, lds);
    }
  }
  if (mask & 16) {
    PP pp = get_params();
    const int team = tidx() >> 8;
    const int nA2 = g_nt(g) / 64;
#pragma unroll 1
    for (int v = blockIdx.x; v < nA2; v += gridDim.x) { const int t2 = 2 * v + team; a_tile(pp, l, t2 >> 2, t2 & 3, lds + team * TEAM_LDS); }
  }
}

DI void phase_merge(PP pp, int l, int g, char* lds) {
  const int ntm = g_nt(g) / 256, ntn = 8, ntiles = ntm * ntn;
  const int lane = tidx() & 63, wid = tidx() >> 6, wr = wid >> 2, wc = wid & 3, fr = lane & 15, fq = lane >> 4;
  bool pre = false;
#pragma unroll 1
  for (int u = blockIdx.x; u < ntiles; u += gridDim.x) {
    int tm, tn; tile_order(swz(u, ntiles), ntm, ntn, tm, tn);
    const int row0 = tm * 256, col0 = tn * 128;
    const bf16_t* Hrow = p.H + (size_t)(g_t0(g) + row0) * D;
    f32x4 macc[8][2]; zero_acc<2>(macc);
#pragma unroll 1
    for (int i = 0; i < 3; ++i) {
      unsigned gp[8][2][2];
      const bf16_t* Wb = (i == 0 ? p.WaT : i == 1 ? p.WbT : p.WcT) + ((size_t)l * 1024 + col0) * 512;
      {
        f32x4 ga[8][2]; zero_acc<2>(ga);
        gemm512<2, 3>(Hrow, D, p.WmgT + ((size_t)l * 3072 + i * 1024 + col0) * D, D, D, ga, lds, pre);
        gemm_pre<2, 3>(p.Y + (size_t)row0 * YC + i * 512, YC, Wb, 512, lds);
#pragma unroll
        for (int n = 0; n < 2; ++n) {
          const float bg = p.b_mgate[l * 3072 + i * 1024 + col0 + wc * 32 + n * 16 + fr];
#pragma unroll
          for (int m = 0; m < 8; ++m) {
            gp[m][n][0] = pk2(sigmoidf(ga[m][n][0] + bg), sigmoidf(ga[m][n][1] + bg));
            gp[m][n][1] = pk2(sigmoidf(ga[m][n][2] + bg), sigmoidf(ga[m][n][3] + bg));
          }
        }
      }
      f32x4 ya[8][2]; zero_acc<2>(ya);
      gemm512<2, 3>(p.Y + (size_t)row0 * YC + i * 512, YC, Wb, 512, 512, ya, lds, true);
      pre = false;
      if (i < 2) {
        gemm_pre<2, 3>(Hrow, D, p.WmgT + ((size_t)l * 3072 + (i + 1) * 1024 + col0) * D, D, lds);
        pre = true;
      } else if (u + (int)gridDim.x < ntiles) {
        int tm2, tn2; tile_order(swz(u + gridDim.x, ntiles), ntm, ntn, tm2, tn2);
        gemm_pre<2, 3>(p.H + (size_t)(g_t0(g) + tm2 * 256) * D, D, p.WmgT + ((size_t)l * 3072 + tn2 * 128) * D, D, lds);
        pre = true;
      }
#pragma unroll
      for (int m = 0; m < 8; ++m)
#pragma unroll
        for (int n = 0; n < 2; ++n) {
          macc[m][n][0] += bflo(gp[m][n][0]) * ya[m][n][0]; macc[m][n][1] += bfhi(gp[m][n][0]) * ya[m][n][1];
          macc[m][n][2] += bflo(gp[m][n][1]) * ya[m][n][2]; macc[m][n][3] += bfhi(gp[m][n][1]) * ya[m][n][3];
        }
    }
    {
      const int t2 = tidx(), lane = t2 & 63, wid = t2 >> 6, wr = wid >> 2, wc = wid & 3, fr = lane & 15, fq = lane >> 4;
      bf16_t* st = (bf16_t*)(lds + 98304 + wid * 5120);
      bf16_t* mrow = p.Z + (size_t)(row0 + wr * 128) * D + col0 + wc * 32;
#pragma unroll
      for (int half = 0; half < 2; ++half) {
#pragma unroll
        for (int mm = 0; mm < 4; ++mm)
#pragma unroll
          for (int n = 0; n < 2; ++n)
#pragma unroll
            for (int jj = 0; jj < 4; ++jj) st[(mm * 16 + fq * 4 + jj) * 40 + n * 16 + fr] = f2bf(macc[half * 4 + mm][n][jj]);
        asm volatile("s_waitcnt lgkmcnt(0)" ::: "memory");
#pragma unroll
        for (int i = 0; i < 4; ++i) {
          const int id = lane + 64 * i, rowl = id >> 2, ch = id & 3;
          const u32x4 w = *(const u32x4*)(st + rowl * 40 + ch * 8);
          *(u32x4*)(mrow + (size_t)(half * 64 + rowl) * D + ch * 8) = w;
        }
        asm volatile("s_waitcnt lgkmcnt(0)" ::: "memory");
      }
    }
  }
}

DI void phase_out(PP pp, int l, int g, char* lds) {
  const int ntm = g_nt(g) / 256, ntn = 8, ntiles = ntm * ntn;
  const int lane = tidx() & 63, wid = tidx() >> 6, wr = wid >> 2, wc = wid & 3, fr = lane & 15, fq = lane >> 4;
  bool pre = false;
#pragma unroll 1
  for (int u = blockIdx.x; u < ntiles; u += gridDim.x) {
    int tm, tn; tile_order(swz(u, ntiles), ntm, ntn, tm, tn);
    const int row0 = tm * 256, col0 = tn * 128;
    f32x4 acc[8][2]; zero_acc<2>(acc);
    gemm512<2, 3>(p.Z + (size_t)row0 * D, D, p.WoT + ((size_t)l * 1024 + col0) * D, D, D, acc, lds, pre);
    pre = false;
    if (u + (int)gridDim.x < ntiles) {
      int tm2, tn2; tile_order(swz(u + gridDim.x, ntiles), ntm, ntn, tm2, tn2);
      gemm_pre<2, 3>(p.Z + (size_t)(tm2 * 256) * D, D, p.WoT + ((size_t)l * 1024 + tn2 * 128) * D, D, lds);
      pre = true;
    }
    const int tk0 = g_t0(g) + row0 + wr * 128;
    const int cid = tk0 < NCTX ? 0 : 1 + ((tk0 - NCTX) >> 12);
    const float* xin0 = (l == 0) ? (tk0 < NCTX ? p.x_prompt + (size_t)tk0 * D : p.x_sample + (size_t)(tk0 - NCTX) * D) : p.out + (size_t)tk0 * D;
    float* xo0 = p.out + (size_t)tk0 * D;
    float* st = (float*)(lds + 98304 + wid * 4608);
    const float gate0 = p.mods[(size_t)(l * 9 + cid) * 3072 + 2048 + col0 + wc * 32 + fr];
    const float gate1 = p.mods[(size_t)(l * 9 + cid) * 3072 + 2048 + col0 + wc * 32 + 16 + fr];
#pragma unroll
    for (int q = 0; q < 4; ++q) {
#pragma unroll
      for (int mm = 0; mm < 2; ++mm)
#pragma unroll
        for (int jj = 0; jj < 4; ++jj) {
          st[(mm * 16 + fq * 4 + jj) * 36 + fr] = gate0 * acc[2 * q + mm][0][jj];
          st[(mm * 16 + fq * 4 + jj) * 36 + 16 + fr] = gate1 * acc[2 * q + mm][1][jj];
        }
      asm volatile("s_waitcnt lgkmcnt(0)" ::: "memory");
#pragma unroll
      for (int i = 0; i < 4; ++i) {
        const int id = lane + 64 * i, rowl = id >> 3, ch = id & 7;
        const f32x4 v = *(const f32x4*)(st + rowl * 36 + ch * 4);
        const size_t off = (size_t)(q * 32 + rowl) * D + col0 + wc * 32 + ch * 4;
        const f32x4 x4 = *(const f32x4*)(xin0 + off);
        *(f32x4*)(xo0 + off) = ALPHA * x4 + v;
      }
      asm volatile("s_waitcnt lgkmcnt(0)" ::: "memory");
    }
  }
}

#undef p
__global__ void __launch_bounds__(512) fwd_kernel(Params p_arg) {
  __shared__ __attribute__((aligned(1024))) char smem[SMEM_BYTES];
  cg::grid_group grid = cg::this_grid();
  const int ph_lo = get_params()->phase_lo, ph_hi = get_params()->phase_hi;
  unsigned nbar = 0;
#pragma unroll 1
  for (int ph = ph_lo; ph < ph_hi; ++ph) {
    PP pp = get_params();
    bool sync_after = true;
    if (ph == 0) {
      if (blockIdx.x == 0 && __builtin_amdgcn_workitem_id_x() == 0) __hip_atomic_store(pp->bar, 0u, __ATOMIC_RELAXED, __HIP_MEMORY_SCOPE_AGENT);
      if (ONLY < 0 || ONLY == 0) phase0(pp, smem);
    }
    else if (ph == 1) { if (ONLY < 0 || ONLY == 1) ln_phase(pp, 0, 0, NTOK, 0); }
    else {
      const int q = ph - 2, lg = q / 5, sub = q % 5, l = lg >> 1, g = lg & 1;
      if (sub == 0) { if (ONLY < 0 || ONLY == 2) phase_in(pp, l, g, smem); }
      else if (sub == 1) { if (ONLY < 0 || ONLY == 3) phase_mix(pp, l, g, smem); }
      else if (sub == 2) { if (ONLY < 0 || ONLY == 4) phase_merge(pp, l, g, smem); }
      else if (sub == 3) { if (ONLY < 0 || ONLY == 5) phase_out(pp, l, g, smem); }
      else { if (ONLY < 0 || ONLY == 6) ln_phase(pp, l, g_t0(g), g_nt(g), 1); sync_after = false; }
    }
    if (sync_after && ph + 1 < ph_hi) {
      if (ph == 0) grid.sync();
      else { ++nbar; grid_bar(pp->bar, nbar * gridDim.x); }
    }
#if REPEAT_SUB >= 0
    if (ph >= 2 && (ph - 2) % 5 == REPEAT_SUB) {
      const int q = ph - 2, lg = q / 5, l = lg >> 1, g = lg & 1;
      if (REPEAT_SUB == 0) phase_in(pp, l, g, smem);
      else if (REPEAT_SUB == 1) phase_mix(pp, l, g, smem, MIXMASK);
      else if (REPEAT_SUB == 2) phase_merge(pp, l, g, smem);
      grid.sync();
    }
#endif
  }
}

static size_t align_up(size_t v) { return (v + 255) & ~(size_t)255; }

extern "C" void kernel_launch(void* const* d_in, const int* in_sizes, int n_in, void* d_out, int out_size, void* d_ws, size_t ws_size,
                              hipStream_t stream) {
  Params p{};
  const float** ip = (const float**)&p;
  for (int i = 0; i < 29; ++i) ip[i] = (const float*)d_in[i];
  p.out = (float*)d_out;
  char* w = (char*)d_ws;
  size_t off = 0;
  auto take = [&](size_t bytes) { char* r = w + off; off += align_up(bytes); return r; };
  p.WinT = (bf16_t*)take((size_t)4 * DIN * D * 2);
  p.WmgT = (bf16_t*)take((size_t)4 * 3072 * D * 2);
  p.WaT = (bf16_t*)take((size_t)4 * 1024 * 512 * 2);
  p.WbT = (bf16_t*)take((size_t)4 * 1024 * 512 * 2);
  p.WcT = (bf16_t*)take((size_t)4 * 1024 * 512 * 2);
  p.WoT = (bf16_t*)take((size_t)4 * 1024 * 1024 * 2);
  p.Wsp = (bf16_t*)take((size_t)4 * 4 * 128 * 128 * 2);
  p.cdk = (bf16_t*)take((size_t)8 * 262144 * 2);
  p.cdvT = (bf16_t*)take((size_t)8 * 262144 * 2);
  p.cnk = (bf16_t*)take((size_t)8 * 262144 * 2);
  p.cnvT = (bf16_t*)take((size_t)8 * 262144 * 2);
  p.H = (bf16_t*)take((size_t)NTOK * D * 2);
  p.Z = (bf16_t*)take((size_t)TG * ZC * 2);
  p.Y = (bf16_t*)take((size_t)TG * YC * 2);
  p.VTa = (bf16_t*)take((size_t)TG * 512 * 2);
  p.VTbL = (bf16_t*)take((size_t)4 * 4 * 128 * 4096 * 2);
  p.VTbC = (bf16_t*)take((size_t)16 * 4 * 128 * 256 * 2);
  p.VTcL = (bf16_t*)take((size_t)4 * 8 * 64 * 4096 * 2);
  p.VTcC = (bf16_t*)take((size_t)16 * 8 * 64 * 256 * 2);
  p.mods = (float*)take((size_t)4 * 9 * 3072 * 4);
  p.rope = (float*)take((size_t)64 * 16 * 2 * 4);
  p.lam = (float*)take(256);
  p.bar = (unsigned*)take(256);
  for (int l = 0; l < 4; ++l) p.lam_init[l] = (float)(0.8 - 0.6 * exp(-0.3 * (double)l));
  p.phase_lo = 0; p.phase_hi = 2 + 8 * 5;
  if (off > ws_size) { fprintf(stderr, "workspace too small: need %zu have %zu\n", off, ws_size); return; }

  static int grid_blocks = 0;
  if (!grid_blocks) {
    int dev = 0, cus = 0, per_cu = 0;
    (void)hipGetDevice(&dev);
    (void)hipDeviceGetAttribute(&cus, hipDeviceAttributeMultiprocessorCount, dev);
    (void)hipOccupancyMaxActiveBlocksPerMultiprocessor(&per_cu, fwd_kernel, NTHR, 0);
    if (per_cu < 1) per_cu = 1;
    if (per_cu > 1) per_cu = 1;
    grid_blocks = cus * per_cu;
  }
  void* args[] = {&p};
  hipError_t e = hipLaunchCooperativeKernel((void*)fwd_kernel, dim3(grid_blocks), dim3(NTHR), args, 0, stream);
  if (e != hipSuccess) fprintf(stderr, "cooperative launch failed: %s (grid %d)\n", hipGetErrorString(e), grid_blocks);
}
```

```cpp
#include <hip/hip_runtime.h>
#include <hip/hip_cooperative_groups.h>
#include <cstdio>
#include <cstdint>
namespace cg = cooperative_groups;

#define DI __device__ __forceinline__
typedef unsigned short bf16_t;
typedef short bf16x8 __attribute__((ext_vector_type(8)));
typedef float f32x16 __attribute__((ext_vector_type(16)));
typedef float f32x4 __attribute__((ext_vector_type(4)));
typedef float f32x2 __attribute__((ext_vector_type(2)));
typedef unsigned u32x4 __attribute__((ext_vector_type(4)));
typedef unsigned u32x2 __attribute__((ext_vector_type(2)));
typedef __bf16 bf2_t __attribute__((ext_vector_type(2)));
typedef _Float16 h2_t __attribute__((ext_vector_type(2)));

#define MFMA(a, b, c) __builtin_amdgcn_mfma_f32_32x32x16_bf16((a), (b), (c), 0, 0, 0)
#define MFMA16(a, b, c) __builtin_amdgcn_mfma_f32_16x16x32_bf16((a), (b), (c), 0, 0, 0)

constexpr int NTHR = 512;
constexpr int D = 1024, NCTX = 4096, NTOK = 36864, DIN = 5632, ZC = 4096, YC = 1536;
constexpr int TG = 20480;
constexpr float ALPHA = 1.6817928305074290f;
constexpr float LOG2E = 1.4426950408889634f;
constexpr float QS = 0.125f * LOG2E;
constexpr float EPS = 1e-6f;
constexpr int SMEM_BYTES = 147456;
constexpr int TEAM_LDS = 53248;
#ifndef ONLY
#define ONLY -1
#endif
#ifndef MIXMASK
#define MIXMASK 31
#endif
#ifndef REPEAT_SUB
#define REPEAT_SUB -1
#endif

struct Params {
  const float *x_prompt, *x_sample, *c, *cache_diff_k, *cache_diff_v, *cache_na_k, *cache_na_v, *c_ctx,
      *w_ada, *b_ada, *w_in, *sg_norm_g, *sg_norm_b, *w_spatial, *b_spatial,
      *lambda_q1, *lambda_k1, *lambda_q2, *lambda_k2, *diff_subln_g, *na_rel_bias,
      *w_br_a, *w_br_b, *w_br_c, *w_mgate, *b_mgate, *w_out, *ln_g, *ln_b;
  float* out;
  bf16_t *WinT, *WmgT, *WaT, *WbT, *WcT, *WoT, *Wsp, *cdk, *cdvT, *cnk, *cnvT, *H, *Z, *Y, *VTa, *VTbL, *VTbC, *VTcL, *VTcC;
  float *mods, *rope, *lam;
  unsigned* bar;
  float lam_init[4];
  int phase_lo, phase_hi;
};

typedef const __attribute__((address_space(4))) Params* PP;
#define p (*pp)
DI PP get_params() { PP k = (PP)__builtin_amdgcn_kernarg_segment_ptr(); asm volatile("" : "+s"(k)); return k; }
DI int tidx() { int t = __builtin_amdgcn_workitem_id_x(); asm volatile("" : "+v"(t)); return t; }
DI unsigned pk2(float a, float b) { f32x2 v = {a, b}; bf2_t r = __builtin_convertvector(v, bf2_t); return __builtin_bit_cast(unsigned, r); }
DI bf16_t f2bf(float a) { return (bf16_t)(pk2(a, 0.f) & 0xffffu); }
DI float bflo(unsigned u) { return __uint_as_float(u << 16); }
DI float bfhi(unsigned u) { return __uint_as_float(u & 0xffff0000u); }
DI float bf2f(bf16_t v) { return __uint_as_float(((unsigned)v) << 16); }
DI int crow(int i, int h) { return (i & 3) + 8 * (i >> 2) + 4 * h; }
DI float fexp2(float x) { return __builtin_amdgcn_exp2f(x); }
DI float silu(float v) { return v * __builtin_amdgcn_rcpf(1.f + __expf(-v)); }
DI float sigmoidf(float v) { return __builtin_amdgcn_rcpf(1.f + __expf(-v)); }
DI int clampi(int v, int lo, int hi) { return v < lo ? lo : (v > hi ? hi : v); }
DI float wave_sum(float v) {
#pragma unroll
  for (int o = 32; o >= 1; o >>= 1) v += __shfl_xor(v, o);
  return v;
}
DI void bar_lds() { asm volatile("s_waitcnt lgkmcnt(0)" ::: "memory"); __builtin_amdgcn_s_barrier(); asm volatile("" ::: "memory"); }
DI void grid_bar(unsigned* ctr, unsigned target) {
  asm volatile("s_waitcnt vmcnt(0)" ::: "memory");
  __syncthreads();
  if (__builtin_amdgcn_workitem_id_x() == 0) {
    __builtin_amdgcn_fence(__ATOMIC_RELEASE, "agent");
    asm volatile("s_waitcnt vmcnt(0)" ::: "memory");
    (void)__hip_atomic_fetch_add(ctr, 1u, __ATOMIC_RELAXED, __HIP_MEMORY_SCOPE_AGENT);
    while (__hip_atomic_load(ctr, __ATOMIC_RELAXED, __HIP_MEMORY_SCOPE_AGENT) < target) __builtin_amdgcn_s_sleep(1);
    __builtin_amdgcn_fence(__ATOMIC_ACQUIRE, "agent");
    asm volatile("s_waitcnt vmcnt(0)" ::: "memory");
  }
  __syncthreads();
}
DI int g_t0(int g) { return g ? TG : 0; }
DI int g_nt(int g) { return g ? (NTOK - TG) : TG; }

DI void transpose_tile(const float* __restrict__ src, int R, int C, bf16_t* __restrict__ dst, int r0, int c0, char* lds) {
  float* tile = (float*)lds;
  const int t = tidx();
  __syncthreads();
#pragma unroll
  for (int i = 0; i < 2; ++i) {
    const int row = (t >> 4) + 32 * i, col = (t & 15) * 4;
    const f32x4 v = *(const f32x4*)(src + (size_t)(r0 + row) * C + c0 + col);
    tile[row * 65 + col + 0] = v.x; tile[row * 65 + col + 1] = v.y; tile[row * 65 + col + 2] = v.z; tile[row * 65 + col + 3] = v.w;
  }
  __syncthreads();
  const int n = t >> 3, kc = t & 7;
  float f[8];
#pragma unroll
  for (int j = 0; j < 8; ++j) f[j] = tile[(kc * 8 + j) * 65 + n];
  u32x4 w = {pk2(f[0], f[1]), pk2(f[2], f[3]), pk2(f[4], f[5]), pk2(f[6], f[7])};
  *(u32x4*)(dst + (size_t)(c0 + n) * R + r0 + kc * 8) = w;
}
DI void transpose_unit(int u, const float* src, bf16_t* dst, int R, int C, char* lds) {
  const int tc = C >> 6, per = (R >> 6) * tc;
  const int b = u / per, rem = u - b * per;
  const int r0 = (rem / tc) * 64, c0 = (rem % tc) * 64;
  transpose_tile(src + (size_t)b * R * C, R, C, dst + (size_t)b * R * C, r0, c0, lds);
}
DI void transpose_tile_w(const float* __restrict__ src, int R, int C, bf16_t* __restrict__ dst, int r0, int c0, char* lds) {
  float* tile = (float*)lds;
  const int t = tidx();
  __syncthreads();
  f32x4 v[4];
#pragma unroll
  for (int i = 0; i < 4; ++i) { const int idx = t + 512 * i, row = idx >> 5, col = (idx & 31) * 4; v[i] = *(const f32x4*)(src + (size_t)(r0 + row) * C + c0 + col); }
#pragma unroll
  for (int i = 0; i < 4; ++i) {
    const int idx = t + 512 * i, row = idx >> 5, col = (idx & 31) * 4;
    tile[row * 129 + col + 0] = v[i].x; tile[row * 129 + col + 1] = v[i].y; tile[row * 129 + col + 2] = v[i].z; tile[row * 129 + col + 3] = v[i].w;
  }
  __syncthreads();
#pragma unroll
  for (int i = 0; i < 2; ++i) {
    const int idx = t + 512 * i, n = idx >> 3, kc = idx & 7;
    float f[8];
#pragma unroll
    for (int j = 0; j < 8; ++j) f[j] = tile[(kc * 8 + j) * 129 + n];
    u32x4 w = {pk2(f[0], f[1]), pk2(f[2], f[3]), pk2(f[4], f[5]), pk2(f[6], f[7])};
    *(u32x4*)(dst + (size_t)(c0 + n) * R + r0 + kc * 8) = w;
  }
}
DI void transpose_unit_w(int u, const float* src, bf16_t* dst, int R, int C, char* lds) {
  const int tc = C >> 7, per = (R >> 6) * tc;
  const int b = u / per, rem = u - b * per;
  const int r0 = (rem / tc) * 64, c0 = (rem % tc) * 128;
  transpose_tile_w(src + (size_t)b * R * C, R, C, dst + (size_t)b * R * C, r0, c0, lds);
}
DI void conv_unit(const float* __restrict__ src, bf16_t* __restrict__ dst) {
  const int t = tidx();
  const f32x4 a = *(const f32x4*)(src + t * 8), b = *(const f32x4*)(src + t * 8 + 4);
  u32x4 w = {pk2(a.x, a.y), pk2(a.z, a.w), pk2(b.x, b.y), pk2(b.z, b.w)};
  *(u32x4*)(dst + t * 8) = w;
}

DI void mods_unit(PP pp, int u, char* lds) {
  const int l = u / 48, cb = u % 48, t = tidx();
  float* sc = (float*)lds;
  __syncthreads();
  for (int i = t; i < 9 * 1024; i += NTHR) {
    const int j = i >> 10, k = i & 1023;
    const float v = (j == 0) ? p.c_ctx[k] : p.c[(j - 1) * 1024 + k];
    sc[i] = silu(v);
  }
  __syncthreads();
  const int cq = t & 15, kg = t >> 4;
  f32x4 a[9];
#pragma unroll
  for (int j = 0; j < 9; ++j) a[j] = (f32x4){0.f, 0.f, 0.f, 0.f};
  const float* w = p.w_ada + (size_t)l * 1024 * 3072 + cb * 64 + cq * 4;
#pragma unroll 4
  for (int k = kg * 32; k < kg * 32 + 32; ++k) {
    const f32x4 wv = *(const f32x4*)(w + (size_t)k * 3072);
#pragma unroll
    for (int j = 0; j < 9; ++j) a[j] += sc[j * 1024 + k] * wv;
  }
  float* red = sc + 9 * 1024;
#pragma unroll
  for (int j = 0; j < 9; ++j) *(f32x4*)(red + (kg * 9 + j) * 64 + cq * 4) = a[j];
  __syncthreads();
  for (int i = t; i < 9 * 64; i += NTHR) {
    const int j = i >> 6, c2 = i & 63;
    float sm = 0.f;
#pragma unroll 8
    for (int k = 0; k < 32; ++k) sm += red[(k * 9 + j) * 64 + c2];
    p.mods[(size_t)(l * 9 + j) * 3072 + cb * 64 + c2] = sm + p.b_ada[l * 3072 + cb * 64 + c2];
  }
}

DI void phase0(PP pp, char* lds) {
  constexpr int U_MODS = 192, U_ROPE = 1, U_LAM = 1, U_WSP = 64;
  constexpr int U_WIN = 4 * 16 * 44, U_WMG = 4 * 16 * 24, U_WBR = 4 * 8 * 8, U_WO = 4 * 16 * 8;
  constexpr int o_rope = U_MODS, o_lam = o_rope + U_ROPE, o_wsp = o_lam + U_LAM, o_win = o_wsp + U_WSP,
                o_wmg = o_win + U_WIN, o_wa = o_wmg + U_WMG, o_wb = o_wa + U_WBR, o_wc = o_wb + U_WBR, o_wo = o_wc + U_WBR, total = o_wo + U_WO;
  const int t = tidx();
  for (int u = blockIdx.x; u < total; u += gridDim.x) {
    if (u < o_rope) mods_unit(pp, u, lds);
    else if (u < o_lam) {
      for (int i = t; i < 1024; i += NTHR) {
        const int pos = i >> 4, f = i & 15;
        const float inv = exp2f(-(float)f * 0.83048202372184058f);
        const float ang = (float)pos * inv;
        p.rope[i * 2] = __cosf(ang); p.rope[i * 2 + 1] = __sinf(ang);
      }
    } else if (u < o_wsp) {
      if (t < 4) {
        float d1 = 0.f, d2 = 0.f;
        for (int i = 0; i < 64; ++i) { d1 += p.lambda_q1[t * 64 + i] * p.lambda_k1[t * 64 + i]; d2 += p.lambda_q2[t * 64 + i] * p.lambda_k2[t * 64 + i]; }
        p.lam[t] = expf(d1) - expf(d2) + p.lam_init[t];
      }
    } else if (u < o_win) { const int v = u - o_wsp; conv_unit(p.w_spatial + (size_t)v * 4096, p.Wsp + (size_t)v * 4096); }
    else if (u < o_wmg) transpose_unit_w(u - o_win, p.w_in, p.WinT, 1024, DIN, lds);
    else if (u < o_wa) transpose_unit_w(u - o_wmg, p.w_mgate, p.WmgT, 1024, 3072, lds);
    else if (u < o_wb) transpose_unit_w(u - o_wa, p.w_br_a, p.WaT, 512, 1024, lds);
    else if (u < o_wc) transpose_unit_w(u - o_wb, p.w_br_b, p.WbT, 512, 1024, lds);
    else if (u < o_wo) transpose_unit_w(u - o_wc, p.w_br_c, p.WcT, 512, 1024, lds);
    else transpose_unit_w(u - o_wo, p.w_out, p.WoT, 1024, 1024, lds);
  }
}

DI void ln_phase(PP pp, int l, int tok0, int ntok, int mode) {
  const int lane = tidx() & 63, wid = tidx() >> 6;
  f32x4 gg[4], bb[4], sh[4], sc[4];
#pragma unroll
  for (int k = 0; k < 4; ++k) {
    gg[k] = bb[k] = sh[k] = sc[k] = (f32x4){0.f, 0.f, 0.f, 0.f};
    if (mode == 1) { gg[k] = *(const f32x4*)(p.ln_g + l * D + k * 256 + lane * 4); bb[k] = *(const f32x4*)(p.ln_b + l * D + k * 256 + lane * 4); }
  }
  const int ln = (mode == 0) ? 0 : l + 1;
  int cur_cid = -1;
  for (int u = blockIdx.x; u * 8 < ntok; u += gridDim.x) {
    const int tk = tok0 + u * 8 + wid;
    const int cid = tk < NCTX ? 0 : 1 + ((tk - NCTX) >> 12);
    float* xs = p.out + (size_t)tk * D;
    const float* xin = (mode == 0) ? (tk < NCTX ? p.x_prompt + (size_t)tk * D : p.x_sample + (size_t)(tk - NCTX) * D) : xs;
    f32x4 v[4];
#pragma unroll
    for (int k = 0; k < 4; ++k) v[k] = *(const f32x4*)(xin + k * 256 + lane * 4);
    if (cid != cur_cid && !(mode == 1 && l == 3)) {
      const float* md = p.mods + (size_t)(ln * 9 + cid) * 3072;
#pragma unroll
      for (int k = 0; k < 4; ++k) { sh[k] = *(const f32x4*)(md + k * 256 + lane * 4); sc[k] = *(const f32x4*)(md + 1024 + k * 256 + lane * 4); }
      cur_cid = cid;
    }
    if (mode == 1) {
      float s = 0.f;
#pragma unroll
      for (int k = 0; k < 4; ++k) s += (v[k].x + v[k].y) + (v[k].z + v[k].w);
      const float mu = wave_sum(s) * (1.f / 1024.f);
      float q = 0.f;
#pragma unroll
      for (int k = 0; k < 4; ++k) { v[k] -= mu; q += (v[k].x * v[k].x + v[k].y * v[k].y) + (v[k].z * v[k].z + v[k].w * v[k].w); }
      const float rstd = rsqrtf(wave_sum(q) * (1.f / 1024.f) + EPS);
#pragma unroll
      for (int k = 0; k < 4; ++k) {
        v[k] = v[k] * rstd * gg[k] + bb[k];
        *(f32x4*)(xs + k * 256 + lane * 4) = v[k];
      }
      if (l == 3) continue;
    }
    float s = 0.f;
#pragma unroll
    for (int k = 0; k < 4; ++k) s += (v[k].x + v[k].y) + (v[k].z + v[k].w);
    const float mu = wave_sum(s) * (1.f / 1024.f);
    float q = 0.f;
#pragma unroll
    for (int k = 0; k < 4; ++k) { v[k] -= mu; q += (v[k].x * v[k].x + v[k].y * v[k].y) + (v[k].z * v[k].z + v[k].w * v[k].w); }
    const float rstd = rsqrtf(wave_sum(q) * (1.f / 1024.f) + EPS);
#pragma unroll
    for (int k = 0; k < 4; ++k) {
      const f32x4 hv = v[k] * rstd * (1.f + sc[k]) + sh[k];
      u32x2 w = {pk2(hv.x, hv.y), pk2(hv.z, hv.w)};
      *(u32x2*)(p.H + (size_t)tk * D + k * 256 + lane * 4) = w;
    }
  }
}

DI int lds_byte(int r, int c) { const int st = (r >> 4) * 2 + (c >> 5), ob = (r & 15) * 64 + (c & 31) * 2; return st * 1024 + (ob ^ (((ob >> 9) & 1) << 5)); }
DI void stage_rc(int b, int& R, int& C) { const int st = b >> 10, sb = b & 1023, swz = sb ^ (((sb >> 9) & 1) << 5); R = (st >> 1) * 16 + swz / 64; C = (st & 1) * 32 + (swz % 64) / 2; }

template <int NT16, int NST>
DI void gemm_pre(const bf16_t* __restrict__ A, int lda, const bf16_t* __restrict__ Bt, int ldb, char* lds) {
  constexpr int TA = 256 * 128, TB = 64 * NT16 * 128, STAGE = TA + TB, GLA = 4, GLB = NT16;
  const int tid = tidx(), lane = tid & 63, wid = tid >> 6;
#pragma unroll
  for (int st = 0; st < NST - 1; ++st) {
#pragma unroll
    for (int i = 0; i < GLA; ++i) { int R, C; stage_rc(wid * 1024 + i * 8192 + lane * 16, R, C);
      __builtin_amdgcn_global_load_lds((const unsigned*)(A + (size_t)R * lda + C + st * 64), (unsigned*)(lds + st * STAGE + wid * 1024 + i * 8192), 16, 0, 0); }
#pragma unroll
    for (int i = 0; i < GLB; ++i) { int R, C; stage_rc(wid * 1024 + i * 8192 + lane * 16, R, C);
      __builtin_amdgcn_global_load_lds((const unsigned*)(Bt + (size_t)R * ldb + C + st * 64), (unsigned*)(lds + st * STAGE + TA + wid * 1024 + i * 8192), 16, 0, 0); }
  }
}
template <int NT16, int NST = 2>
DI void gemm512(const bf16_t* __restrict__ A, int lda, const bf16_t* __restrict__ Bt, int ldb, int K, f32x4 (&acc)[8][NT16], char* lds, bool pre = false) {
  constexpr int TA = 256 * 128, TB = 64 * NT16 * 128, STAGE = TA + TB, GLA = 4, GLB = NT16;
  static_assert(NST * STAGE <= SMEM_BYTES, "LDS ring too large");
  const int tid = tidx(), lane = tid & 63, wid = tid >> 6, wr = wid >> 2, wc = wid & 3, fr = lane & 15, fq = lane >> 4;
  unsigned goa[GLA], gob[GLB];
#pragma unroll
  for (int i = 0; i < GLA; ++i) { int R, C; stage_rc(wid * 1024 + i * 8192 + lane * 16, R, C); goa[i] = (unsigned)(R * lda + C); }
#pragma unroll
  for (int i = 0; i < GLB; ++i) { int R, C; stage_rc(wid * 1024 + i * 8192 + lane * 16, R, C); gob[i] = (unsigned)(R * ldb + C); }
  const int nt = K >> 6;
  auto issue = [&](char* st, int k0) {
#pragma unroll
    for (int i = 0; i < GLA; ++i) __builtin_amdgcn_global_load_lds((const unsigned*)(A + goa[i] + k0), (unsigned*)(st + wid * 1024 + i * 8192), 16, 0, 0);
#pragma unroll
    for (int i = 0; i < GLB; ++i) __builtin_amdgcn_global_load_lds((const unsigned*)(Bt + gob[i] + k0), (unsigned*)(st + TA + wid * 1024 + i * 8192), 16, 0, 0);
  };
  constexpr int DM = GLA + GLB, SLOTS = (NST == 2) ? 8 : 16;
  auto step = [&](const char* cur, char* dst, int kd, bool dma) {
#pragma unroll
    for (int ks = 0; ks < 2; ++ks) {
      bf16x8 Bf[NT16];
#pragma unroll
      for (int n = 0; n < NT16; ++n) Bf[n] = *(const bf16x8*)(cur + TA + lds_byte(wc * 16 * NT16 + n * 16 + fr, ks * 32 + fq * 8));
#pragma unroll
      for (int mh = 0; mh < 2; ++mh) {
      bf16x8 At[4];
#pragma unroll
      for (int m4 = 0; m4 < 4; ++m4) At[m4] = *(const bf16x8*)(cur + lds_byte(wr * 128 + (mh * 4 + m4) * 16 + fr, ks * 32 + fq * 8));
#pragma unroll
      for (int m4 = 0; m4 < 4; ++m4) {
        const int m = mh * 4 + m4;
#pragma unroll
        for (int n = 0; n < NT16; ++n) acc[m][n] = MFMA16(At[m4], Bf[n], acc[m][n]);
        const int q = ks * 8 + m;
#pragma unroll
        for (int j = 0; j < DM; ++j) {
          if (((2 * j + 1) * SLOTS) / (2 * DM) == q) {
            __builtin_amdgcn_sched_barrier(0);
            if (dma) {
              if (j < 2 * GLB) {
                if (j & 1) __builtin_amdgcn_global_load_lds((const unsigned*)(Bt + gob[j >> 1] + kd), (unsigned*)(dst + TA + wid * 1024 + (j >> 1) * 8192), 16, 0, 0);
                else __builtin_amdgcn_global_load_lds((const unsigned*)(A + goa[j >> 1] + kd), (unsigned*)(dst + wid * 1024 + (j >> 1) * 8192), 16, 0, 0);
              } else {
                __builtin_amdgcn_global_load_lds((const unsigned*)(A + goa[j - GLB] + kd), (unsigned*)(dst + wid * 1024 + (j - GLB) * 8192), 16, 0, 0);
              }
            }
            __builtin_amdgcn_sched_barrier(0);
          }
        }
      }
      }
    }
  };
  if (!pre) __syncthreads();
  if (NST == 2) {
    if (!pre) issue(lds, 0);
    asm volatile("s_waitcnt vmcnt(0)" ::: "memory");
    __syncthreads();
#pragma unroll 1
    for (int t = 0; t < nt; ++t) {
      char* cur = lds + (t & 1) * STAGE;
      char* nxt = lds + ((t & 1) ^ 1) * STAGE;
      step(cur, nxt, (t + 1) * 64, t + 1 < nt);
      asm volatile("s_waitcnt vmcnt(0)" ::: "memory");
      __syncthreads();
    }
  } else {
    if (!pre) { issue(lds, 0); issue(lds + STAGE, 64); }
    asm volatile("s_waitcnt vmcnt(%0)" ::"n"(GLA + GLB) : "memory");
    bar_lds();
    int c0 = 0;
#pragma unroll 1
    for (int t = 0; t < nt; ++t) {
      const int c1 = (c0 == 2) ? 0 : c0 + 1, c2 = (c1 == 2) ? 0 : c1 + 1;
      step(lds + c0 * STAGE, lds + c2 * STAGE, (t + 2) * 64, t + 2 < nt);
      if (t + 2 < nt) asm volatile("s_waitcnt vmcnt(%0)" ::"n"(GLA + GLB) : "memory");
      else asm volatile("s_waitcnt vmcnt(0)" ::: "memory");
      bar_lds();
      c0 = c1;
    }
  }
}
template <int NT16>
DI void zero_acc(f32x4 (&acc)[8][NT16]) {
#pragma unroll
  for (int m = 0; m < 8; ++m)
#pragma unroll
    for (int n = 0; n < NT16; ++n) acc[m][n] = (f32x4){0.f, 0.f, 0.f, 0.f};
}
DI int swz(int u, int total) {
  const int G = gridDim.x, b = blockIdx.x, base = u - b;
  return (base + G <= total && (G & 7) == 0) ? base + (b & 7) * (G >> 3) + (b >> 3) : u;
}
DI void tile_order(int t, int ntm, int ntn, int& tm, int& tn) {
  const int per = 8 * ntn, gi = t / per, fm = gi * 8, gsz = (ntm - fm) < 8 ? (ntm - fm) : 8, rem = t - gi * per;
  tm = fm + rem % gsz; tn = rem / gsz;
}

DI void store_f32_staged(const f32x4 (&acc)[8][4], float* o0, int ldo, int lane, char* ldsw) {
  float* st = (float*)ldsw;
  const int fr = lane & 15, fq = lane >> 4;
#pragma unroll
  for (int q = 0; q < 4; ++q) {
#pragma unroll
    for (int mm = 0; mm < 2; ++mm)
#pragma unroll
      for (int n = 0; n < 4; ++n)
#pragma unroll
        for (int jj = 0; jj < 4; ++jj) st[(mm * 16 + fq * 4 + jj) * 68 + n * 16 + fr] = acc[2 * q + mm][n][jj];
    asm volatile("s_waitcnt lgkmcnt(0)" ::: "memory");
#pragma unroll
    for (int i = 0; i < 8; ++i) {
      const int id = lane + 64 * i, rowl = id >> 4, ch = id & 15;
      const f32x4 v = *(const f32x4*)(st + rowl * 68 + ch * 4);
      *(f32x4*)(o0 + (size_t)(q * 32 + rowl) * ldo + ch * 4) = v;
    }
    asm volatile("s_waitcnt lgkmcnt(0)" ::: "memory");
  }
}
DI void epi_in(PP pp, int l, int g, const f32x4 (&acc)[8][4], int lrow0, int col0, int lane, char* lds) {
  const int fr = lane & 15, fq = lane >> 4;
  const int gtok0 = g_t0(g) + lrow0;
  const bool ctx = gtok0 < NCTX;
  const int j = col0 >> 9, cb = col0 & 511;
  int b, pos0;
  if (ctx) { b = gtok0 >> 8; pos0 = gtok0 & 255; } else { b = (gtok0 - NCTX) >> 12; pos0 = (gtok0 - NCTX) & 4095; }
  const int lb = b & 3;
  bf16_t* zrow = p.Z + (size_t)lrow0 * ZC;
  if (j != 1 && j != 5 && j != 9) {
    const int zcb = (j == 0 ? 0 : j == 2 ? 512 : j == 3 ? 1024 : j == 4 ? 1536 : j == 6 ? 2048 : j == 7 ? 2560 : j == 8 ? 3072 : 3584) + cb;
    const bool act = (j == 2 || j == 6 || j == 10), rope = (!ctx) && (j == 3 || j == 4);
    const float qs = (j == 3 || j == 7) ? QS : 1.f;
    bf16_t* st = (bf16_t*)(lds + (tidx() >> 6) * 9216);
    const float* ropel = (const float*)(lds + 73728);
#pragma unroll
    for (int half = 0; half < 2; ++half) {
#pragma unroll
      for (int mm = 0; mm < 4; ++mm) {
        const int m = half * 4 + mm;
        if (rope) {
#pragma unroll
          for (int jj = 0; jj < 4; ++jj) {
            const int pos = pos0 + m * 16 + fq * 4 + jj;
            const f32x2 cr = *(const f32x2*)(ropel + ((pos >> 6) * 16 + fr) * 2), cc = *(const f32x2*)(ropel + ((pos & 63) * 16 + fr) * 2);
            const float x1 = acc[m][0][jj], x2 = acc[m][1][jj], y1 = acc[m][2][jj], y2 = acc[m][3][jj];
            bf16_t* zp = st + (mm * 16 + fq * 4 + jj) * 72 + fr;
            zp[0] = f2bf((x1 * cr.x - x2 * cr.y) * qs); zp[16] = f2bf((x2 * cr.x + x1 * cr.y) * qs);
            zp[32] = f2bf((y1 * cc.x - y2 * cc.y) * qs); zp[48] = f2bf((y2 * cc.x + y1 * cc.y) * qs);
          }
        } else {
#pragma unroll
          for (int n = 0; n < 4; ++n)
#pragma unroll
            for (int jj = 0; jj < 4; ++jj) {
              const float a = acc[m][n][jj];
              st[(mm * 16 + fq * 4 + jj) * 72 + n * 16 + fr] = f2bf(act ? silu(a) : a * qs);
            }
        }
      }
      asm volatile("s_waitcnt lgkmcnt(0)" ::: "memory");
#pragma unroll
      for (int i = 0; i < 8; ++i) {
        const int rowl = i * 8 + (lane >> 3), ch = lane & 7;
        const u32x4 w = *(const u32x4*)(st + rowl * 72 + ch * 8);
        *(u32x4*)(zrow + (size_t)(half * 64 + rowl) * ZC + zcb + ch * 8) = w;
      }
      asm volatile("s_waitcnt lgkmcnt(0)" ::: "memory");
    }
    if (ctx && (j == 4 || j == 8)) {
      float* o;
      if (j == 4) { const int mm = cb >> 8, hh = (cb >> 6) & 3; o = p.out + (size_t)NTOK * D + ((((size_t)(b * 4 + l) * 2 + mm) * 4 + hh) * 256 + pos0) * 64 + fr; }
      else { const int hh = cb >> 6; o = p.out + (size_t)NTOK * D + 2 * (size_t)8388608 + (((size_t)(b * 4 + l) * 8 + hh) * 256 + pos0) * 64 + fr; }
      store_f32_staged(acc, o - fr, 64, lane, lds + (tidx() >> 6) * 9216);
    }
  } else {
    bf16_t* vt; int ld;
    if (j == 1) { vt = p.VTa + ((size_t)(lrow0 >> 7) * 512 + cb) * 128 + (lrow0 & 127); ld = 128; }
    else if (j == 5) {
      const int hh = cb >> 7, dv0 = cb & 127;
      if (ctx) { vt = p.VTbC + ((size_t)(b * 4 + hh) * 128 + dv0) * 256 + pos0; ld = 256; } else { vt = p.VTbL + ((size_t)(lb * 4 + hh) * 128 + dv0) * 4096 + pos0; ld = 4096; }
    } else {
      const int hh = cb >> 6;
      if (ctx) { vt = p.VTcC + ((size_t)(b * 8 + hh) * 64) * 256 + pos0; ld = 256; } else { vt = p.VTcL + ((size_t)(lb * 8 + hh) * 64) * 4096 + pos0; ld = 4096; }
    }
    {
      bf16_t* st = (bf16_t*)(lds + (tidx() >> 6) * 9216);
#pragma unroll
      for (int half = 0; half < 2; ++half) {
#pragma unroll
        for (int mm = 0; mm < 4; ++mm)
#pragma unroll
          for (int n = 0; n < 4; ++n) {
            const int m = half * 4 + mm;
            u32x2 w = {pk2(acc[m][n][0], acc[m][n][1]), pk2(acc[m][n][2], acc[m][n][3])};
            *(u32x2*)(st + (n * 16 + fr) * 68 + mm * 16 + fq * 4) = w;
          }
        asm volatile("s_waitcnt lgkmcnt(0)" ::: "memory");
#pragma unroll
        for (int i = 0; i < 8; ++i) {
          const int id = lane + 64 * i, dvr = id >> 3, ch = id & 7;
          const u32x2 wa = *(const u32x2*)(st + dvr * 68 + ch * 8), wb = *(const u32x2*)(st + dvr * 68 + ch * 8 + 4);
          u32x4 w = {wa.x, wa.y, wb.x, wb.y};
          *(u32x4*)(vt + (size_t)dvr * ld + half * 64 + ch * 8) = w;
        }
        asm volatile("s_waitcnt lgkmcnt(0)" ::: "memory");
      }
    }
    if (ctx && j != 1) {
      float* o;
      if (j == 5) { const int hh = cb >> 7, dv0 = cb & 127; o = p.out + (size_t)NTOK * D + (size_t)8388608 + (((size_t)(b * 4 + l) * 4 + hh) * 256 + pos0) * 128 + dv0 + fr; }
      else { const int hh = cb >> 6; o = p.out + (size_t)NTOK * D + 3 * (size_t)8388608 + (((size_t)(b * 4 + l) * 8 + hh) * 256 + pos0) * 64 + fr; }
      const int ldo = (j == 5) ? 128 : 64;
      store_f32_staged(acc, o - fr, ldo, lane, lds + (tidx() >> 6) * 9216);
    }
  }
}

DI void phase_in(PP pp, int l, int g, char* lds) {
  const int ntm = g_nt(g) / 256, ntn = DIN / 256, ntiles = ntm * ntn;
  constexpr int U_CONV = 256 + 256 + 128 + 256;
  const int rex = ntiles % (int)gridDim.x, nlight = (int)gridDim.x - rex;
  const bool lightonly = rex > 0 && nlight * 4 >= (int)gridDim.x;
  const int cu0 = lightonly ? (int)blockIdx.x - rex : (int)blockIdx.x, cstep = lightonly ? nlight : (int)gridDim.x;
  for (int u = (cu0 < 0 ? U_CONV : cu0); u < U_CONV; u += cstep) {
    if (u < 256) {
      const int b = 4 * g + (u >> 6); const size_t off = (size_t)(u & 63) * 4096;
      conv_unit(p.cache_diff_k + (size_t)(b * 4 + l) * 262144 + off, p.cdk + (size_t)b * 262144 + off);
    } else if (u < 512) {
      const int v = u - 256, b = 4 * g + (v >> 6); const size_t off = (size_t)(v & 63) * 4096;
      conv_unit(p.cache_na_k + (size_t)(b * 4 + l) * 262144 + off, p.cnk + (size_t)b * 262144 + off);
    } else if (u < 640) {
      const int v = u - 512, b = 4 * g + (v >> 5), hh = (v >> 3) & 3, tl = v & 7;
      transpose_tile_w(p.cache_diff_v + (size_t)((b * 4 + l) * 4 + hh) * 65536, 512, 128, p.cdvT + (size_t)(b * 4 + hh) * 65536, tl * 64, 0, lds);
    } else {
      const int v = u - 640, b = 4 * g + (v >> 6), hh = (v >> 3) & 7, tl = v & 7;
      transpose_tile(p.cache_na_v + (size_t)((b * 4 + l) * 8 + hh) * 32768, 512, 64, p.cnvT + (size_t)(b * 8 + hh) * 32768, tl * 64, 0, lds);
    }
  }
  const int lane = tidx() & 63, wid = tidx() >> 6, wr = wid >> 2, wc = wid & 3;
  __syncthreads();
  *(f32x4*)(lds + 139264 + tidx() * 16) = *(const f32x4*)(p.rope + tidx() * 4);
  __syncthreads();
  bool pre = false;
#pragma unroll 1
  for (int u = blockIdx.x; u < ntiles; u += gridDim.x) {
    int tm, tn; tile_order(swz(u, ntiles), ntm, ntn, tm, tn);
    const int row0 = tm * 256, col0 = tn * 256;
    f32x4 acc[8][4]; zero_acc<4>(acc);
    gemm512<4>(p.H + (size_t)(g_t0(g) + row0) * D, D, p.WinT + ((size_t)l * DIN + col0) * D, D, D, acc, lds, pre);
    pre = false;
    if (u + (int)gridDim.x < ntiles) {
      int tm2, tn2; tile_order(swz(u + gridDim.x, ntiles), ntm, ntn, tm2, tn2);
      gemm_pre<4, 2>(p.H + (size_t)(g_t0(g) + tm2 * 256) * D, D, p.WinT + ((size_t)l * DIN + tn2 * 256) * D, D, lds);
      pre = true;
    }
    epi_in(pp, l, g, acc, row0 + wr * 128, col0 + wc * 64, lane, lds + 65536);
  }
}

struct KVSeg { const bf16_t* K; const bf16_t* VT; int ldk, ldvt, nblk; };

template <int DVT, int MODE, int TEAM>
DI void attn_pass(const bf16_t* __restrict__ Qw, const KVSeg& s0, const KVSeg& s1, f32x16 (&O)[DVT], float& lsum,
                  int na_qrow, int na_qcol, int na_R0, const float* relb, char* lds) {
  constexpr int STG = 9216 + DVT * 32 * 144;
  constexpr int KCH = 512 / TEAM, VCH = DVT * 256 / TEAM;
  const int tt = tidx() & (TEAM - 1), lane = tt & 63, h = lane >> 5, r = lane & 31;
  bf16x8 qf[4];
#pragma unroll
  for (int s = 0; s < 4; ++s) qf[s] = *(const bf16x8*)(Qw + s * 16 + h * 8);
#pragma unroll
  for (int dt = 0; dt < DVT; ++dt)
#pragma unroll
    for (int i = 0; i < 16; ++i) O[dt][i] = 0.f;
  float m = 0.f, l = 0.f;
  f32x16 negm;
#pragma unroll
  for (int i = 0; i < 16; ++i) negm[i] = 0.f;
  u32x4 kr0[KCH], vr0[VCH], kr1[KCH], vr1[VCH];
  const int nblk = s0.nblk + s1.nblk;
  const int lrow = tt >> 3, lkc = tt & 7;
  auto gload = [&](int j, u32x4 (&kreg)[KCH], u32x4 (&vreg)[VCH]) {
    const bool first = j < s0.nblk;
    const bf16_t* Kp = first ? s0.K : s1.K; const bf16_t* Vp = first ? s0.VT : s1.VT;
    const int ldk = first ? s0.ldk : s1.ldk, ldvt = first ? s0.ldvt : s1.ldvt;
    const int key0 = (first ? j : j - s0.nblk) * 64;
#pragma unroll
    for (int i = 0; i < KCH; ++i) kreg[i] = *(const u32x4*)(Kp + (size_t)(key0 + lrow + (TEAM / 8) * i) * ldk + lkc * 8);
#pragma unroll
    for (int i = 0; i < VCH; ++i) vreg[i] = *(const u32x4*)(Vp + (size_t)(lrow + (TEAM / 8) * i) * ldvt + key0 + lkc * 8);
  };
  auto lstore = [&](int buf, const u32x4 (&kreg)[KCH], const u32x4 (&vreg)[VCH]) {
    bf16_t* Ks = (bf16_t*)(lds + buf * STG);
    bf16_t* VTs = (bf16_t*)(lds + buf * STG + 9216);
#pragma unroll
    for (int i = 0; i < KCH; ++i) *(u32x4*)(Ks + (lrow + (TEAM / 8) * i) * 72 + lkc * 8) = kreg[i];
#pragma unroll
    for (int i = 0; i < VCH; ++i) {
      bf16_t* d = VTs + (lrow + (TEAM / 8) * i) * 72 + (lkc >> 1) * 16 + (lkc & 1) * 4;
      u32x2 lo = {vreg[i].x, vreg[i].y}, hi = {vreg[i].z, vreg[i].w};
      *(u32x2*)d = lo; *(u32x2*)(d + 8) = hi;
    }
  };
  gload(0, kr0, vr0);
  if (nblk > 1) gload(1, kr1, vr1);
  __syncthreads();
  lstore(0, kr0, vr0);
  if (nblk > 2) gload(2, kr0, vr0);
#pragma unroll 1
  for (int j = 0; j < nblk; ++j) {
    bar_lds();
    if (j + 1 < nblk) {
      if (j & 1) { lstore(0, kr0, vr0); if (j + 3 < nblk) gload(j + 3, kr0, vr0); }
      else { lstore(1, kr1, vr1); if (j + 3 < nblk) gload(j + 3, kr1, vr1); }
    }
    const bf16_t* Ks = (const bf16_t*)(lds + (j & 1) * STG);
    const bf16_t* VTs = (const bf16_t*)(lds + (j & 1) * STG + 9216);
    const bool local = (MODE == 1) && (j >= s0.nblk);
    int krow = 0; bool active = true;
    if (local) { krow = na_R0 + (j - s0.nblk); const int rs = clampi(na_qrow - 4, 0, 56); active = (krow >= rs) && (krow < rs + 8); }
    if (active) {
      f32x16 S[2];
#pragma unroll
      for (int kt = 0; kt < 2; ++kt) {
        bf16x8 kf[4];
#pragma unroll
        for (int s = 0; s < 4; ++s) kf[s] = *(const bf16x8*)(Ks + (kt * 32 + r) * 72 + s * 16 + h * 8);
        S[kt] = MFMA(kf[0], qf[0], negm);
#pragma unroll
        for (int s = 1; s < 4; ++s) S[kt] = MFMA(kf[s], qf[s], S[kt]);
      }
      if (local) {
        const int dy = krow - na_qrow + 7, cs = clampi(na_qcol - 8, 0, 48);
        const int tcs = 4 * h - cs;
        const float* rb = relb + (dy * 31 + 4 * h - na_qcol + 15 + 48);
#pragma unroll
        for (int kt = 0; kt < 2; ++kt)
#pragma unroll
          for (int i = 0; i < 16; ++i) {
            const int c0 = kt * 32 + (i & 3) + 8 * (i >> 2);
            const bool ok = (unsigned)(c0 + tcs) < 16u;
            S[kt][i] = ok ? S[kt][i] + rb[c0] : -1e30f;
          }
      }
      float mx = S[0][0];
#pragma unroll
      for (int kt = 0; kt < 2; ++kt)
#pragma unroll
        for (int i = 0; i < 16; ++i) mx = fmaxf(mx, S[kt][i]);
      mx = fmaxf(mx, __shfl_xor(mx, 32));
      if (j == 0 || __builtin_amdgcn_ballot_w64(mx > 8.f) != 0ull) {
        const float delta = (j == 0) ? mx : fmaxf(mx, 0.f), alpha = fexp2(-delta);
        m += delta;
#pragma unroll
        for (int i = 0; i < 16; ++i) negm[i] = -m;
#pragma unroll
        for (int kt = 0; kt < 2; ++kt)
#pragma unroll
          for (int i = 0; i < 16; ++i) S[kt][i] -= delta;
        l *= alpha;
#pragma unroll
        for (int dt = 0; dt < DVT; ++dt) O[dt] *= alpha;
      }
      float ps = 0.f;
#pragma unroll
      for (int kt = 0; kt < 2; ++kt)
#pragma unroll
        for (int i = 0; i < 16; ++i) { const float p0 = fexp2(S[kt][i]); S[kt][i] = p0; ps += p0; }
      l += ps;
#pragma unroll
      for (int kt = 0; kt < 2; ++kt)
#pragma unroll
        for (int sp = 0; sp < 2; ++sp) {
          u32x4 pw = {pk2(S[kt][8 * sp + 0], S[kt][8 * sp + 1]), pk2(S[kt][8 * sp + 2], S[kt][8 * sp + 3]),
                      pk2(S[kt][8 * sp + 4], S[kt][8 * sp + 5]), pk2(S[kt][8 * sp + 6], S[kt][8 * sp + 7])};
          const bf16x8 pf = __builtin_bit_cast(bf16x8, pw);
#pragma unroll
          for (int dt = 0; dt < DVT; ++dt) {
            const u32x4 vw = *(const u32x4*)(VTs + (dt * 32 + r) * 72 + kt * 32 + sp * 16 + h * 8);
            O[dt] = MFMA(__builtin_bit_cast(bf16x8, vw), pf, O[dt]);
          }
        }
    }
  }
  l += __shfl_xor(l, 32);
  lsum = l;
}

DI void diff_tile(PP pp, int l, int lrow0, int krow0, int own_blk, int hh, const bf16_t* VTown, int ldvt_own,
                  const bf16_t* cK  , const bf16_t* cVT  , char* lds) {
  constexpr int STG = 2 * 9216 + 128 * 144;
  const int tid = tidx(), lane = tid & 63, wid = tid >> 6, h = lane >> 5, r = lane & 31, qs = wid & 3, mm = wid >> 2;
  const int row = lrow0 + qs * 32 + r;
  const bf16_t* Qw = p.Z + (size_t)row * ZC + 1024 + mm * 256 + hh * 64;
  const bf16_t* K0 = p.Z + (size_t)krow0 * ZC + 1536 + hh * 64;
  const bf16_t* K1 = cK ? cK + (size_t)hh * 32768 : K0;
  const int nblk = own_blk + (cK ? 8 : 0);
  bf16x8 qf[4];
#pragma unroll
  for (int s = 0; s < 4; ++s) qf[s] = *(const bf16x8*)(Qw + s * 16 + h * 8);
  f32x16 O[4];
#pragma unroll
  for (int dt = 0; dt < 4; ++dt)
#pragma unroll
    for (int i = 0; i < 16; ++i) O[dt][i] = 0.f;
  float m = 0.f;
  f32x16 negm;
  float lacc = 0.f;
#pragma unroll
  for (int i = 0; i < 16; ++i) negm[i] = 0.f;
  u32x4 kA[2], vA[2], kB[2], vB[2];
  const int lrow = tid >> 3, lkc = tid & 7;
  const bf16_t* kbase = K0 + (size_t)lrow * ZC + lkc * 8;
  const bf16_t* vbase = VTown + (size_t)lrow * ldvt_own + lkc * 8;
  const bf16_t* ckbase = K1 + (size_t)lrow * 64 + lkc * 8;
  const bf16_t* cvbase = (cK ? cVT : VTown) + (size_t)lrow * 512 + lkc * 8;
  const size_t vrow64 = (size_t)64 * ldvt_own;
  auto gload = [&](int j, u32x4 (&kreg)[2], u32x4 (&vreg)[2]) {
    if (j < own_blk) {
      const size_t ko = (size_t)j * (64 * ZC);
      kreg[0] = *(const u32x4*)(kbase + ko);
      kreg[1] = *(const u32x4*)(kbase + ko + 256);
      vreg[0] = *(const u32x4*)(vbase + j * 64);
      vreg[1] = *(const u32x4*)(vbase + vrow64 + j * 64);
    } else {
      const int jj = j - own_blk;
      kreg[0] = *(const u32x4*)(ckbase + jj * 4096);
      kreg[1] = *(const u32x4*)(ckbase + jj * 4096 + 4 * 32768);
      vreg[0] = *(const u32x4*)(cvbase + jj * 64);
      vreg[1] = *(const u32x4*)(cvbase + 64 * 512 + jj * 64);
    }
  };
  auto lstore = [&](int buf, const u32x4 (&kreg)[2], const u32x4 (&vreg)[2]) {
    bf16_t* Ks = (bf16_t*)(lds + buf * STG);
    bf16_t* VTs = (bf16_t*)(lds + buf * STG + 2 * 9216);
    *(u32x4*)(Ks + lrow * 72 + lkc * 8) = kreg[0];
    *(u32x4*)(Ks + 4608 + lrow * 72 + lkc * 8) = kreg[1];
#pragma unroll
    for (int i = 0; i < 2; ++i) {
      bf16_t* d = VTs + (lrow + 64 * i) * 72 + (lkc >> 1) * 16 + (lkc & 1) * 4;
      u32x2 lo = {vreg[i].x, vreg[i].y}, hi = {vreg[i].z, vreg[i].w};
      *(u32x2*)d = lo; *(u32x2*)(d + 8) = hi;
    }
  };
  auto body = [&](int j) {
    const bf16_t* Ks = (const bf16_t*)(lds + (j & 1) * STG) + mm * 4608;
    const bf16_t* VTs = (const bf16_t*)(lds + (j & 1) * STG + 2 * 9216);
    f32x16 S[2];
#pragma unroll
    for (int kt = 0; kt < 2; ++kt) {
      bf16x8 kf[4];
#pragma unroll
      for (int s = 0; s < 4; ++s) kf[s] = *(const bf16x8*)(Ks + (kt * 32 + r) * 72 + s * 16 + h * 8);
      S[kt] = MFMA(kf[0], qf[0], negm);
#pragma unroll
      for (int s = 1; s < 4; ++s) S[kt] = MFMA(kf[s], qf[s], S[kt]);
    }
    if ((j & 1) == 0) {
      float mx = S[0][0];
#pragma unroll
      for (int kt = 0; kt < 2; ++kt)
#pragma unroll
        for (int i = 0; i < 16; ++i) mx = fmaxf(mx, S[kt][i]);
      mx = fmaxf(mx, __shfl_xor(mx, 32));
      if (j == 0 || __builtin_amdgcn_ballot_w64(mx > 8.f) != 0ull) {
        const float delta = (j == 0) ? mx : fmaxf(mx, 0.f), alpha = fexp2(-delta);
        m += delta;
#pragma unroll
        for (int i = 0; i < 16; ++i) negm[i] = -m;
#pragma unroll
        for (int kt = 0; kt < 2; ++kt)
#pragma unroll
          for (int i = 0; i < 16; ++i) S[kt][i] -= delta;
        lacc *= alpha;
#pragma unroll
        for (int dt = 0; dt < 4; ++dt) O[dt] *= alpha;
      }
    }
    float ps = 0.f;
#pragma unroll
    for (int kt = 0; kt < 2; ++kt)
#pragma unroll
      for (int i = 0; i < 16; ++i) { const float p0 = fexp2(S[kt][i]); S[kt][i] = p0; ps += p0; }
    lacc += ps;
#pragma unroll
    for (int kt = 0; kt < 2; ++kt)
#pragma unroll
      for (int sp = 0; sp < 2; ++sp) {
        u32x4 pw = {pk2(S[kt][8 * sp + 0], S[kt][8 * sp + 1]), pk2(S[kt][8 * sp + 2], S[kt][8 * sp + 3]),
                    pk2(S[kt][8 * sp + 4], S[kt][8 * sp + 5]), pk2(S[kt][8 * sp + 6], S[kt][8 * sp + 7])};
        const bf16x8 pf = __builtin_bit_cast(bf16x8, pw);
        u32x4 vw[4];
#pragma unroll
        for (int dt = 0; dt < 4; ++dt) {
          vw[dt] = *(const u32x4*)(VTs + (dt * 32 + r) * 72 + kt * 32 + sp * 16 + h * 8);
        }
#pragma unroll
        for (int dt = 0; dt < 4; ++dt) O[dt] = MFMA(__builtin_bit_cast(bf16x8, vw[dt]), pf, O[dt]);
      }
  };
  gload(0, kA, vA);
  gload(1, kB, vB);
  __syncthreads();
  lstore(0, kA, vA);
  if (nblk > 2) gload(2, kA, vA);
#pragma unroll 1
  for (int j = 0; j < nblk; j += 2) {
    bar_lds();
    lstore(1, kB, vB);
    if (j + 3 < nblk) gload(j + 3, kB, vB);
    body(j);
    bar_lds();
    if (j + 2 < nblk) { lstore(0, kA, vA); if (j + 4 < nblk) gload(j + 4, kA, vA); }
    body(j + 1);
  }
  const float lsum = lacc + __shfl_xor(lacc, 32);
  float* xch = (float*)lds;
  const float scale = (mm == 0) ? 1.f / lsum : p.lam[l] / lsum;
  __syncthreads();
  if (mm == 1) {
#pragma unroll
    for (int dt = 0; dt < 4; ++dt)
#pragma unroll
      for (int i = 0; i < 16; ++i) xch[((qs * 4 + dt) * 16 + i) * 64 + lane] = O[dt][i] * scale;
  }
  __syncthreads();
  if (mm == 0) {
    float ss = 0.f;
#pragma unroll
    for (int dt = 0; dt < 4; ++dt)
#pragma unroll
      for (int i = 0; i < 16; ++i) { const float o = O[dt][i] * scale - xch[((qs * 4 + dt) * 16 + i) * 64 + lane]; O[dt][i] = o; ss += o * o; }
    ss += __shfl_xor(ss, 32);
    const float rr = rsqrtf(ss * (1.f / 128.f) + EPS) * (1.f - p.lam_init[l]);
    bf16_t* Ys = (bf16_t*)(lds + 65536);
#pragma unroll
    for (int dt = 0; dt < 4; ++dt)
#pragma unroll
      for (int gq = 0; gq < 4; ++gq) {
        const int dv0 = dt * 32 + 8 * gq + 4 * h;
        const f32x4 g4 = *(const f32x4*)(p.diff_subln_g + l * 128 + dv0);
        u32x2 w = {pk2(O[dt][4 * gq + 0] * rr * g4.x, O[dt][4 * gq + 1] * rr * g4.y), pk2(O[dt][4 * gq + 2] * rr * g4.z, O[dt][4 * gq + 3] * rr * g4.w)};
        *(u32x2*)(Ys + (qs * 32 + r) * 132 + dv0) = w;
      }
  }
  __syncthreads();
  {
    const bf16_t* Ys = (const bf16_t*)(lds + 65536);
#pragma unroll
    for (int i = 0; i < 4; ++i) {
      const int id = tid + 512 * i, rowl = id >> 4, c8 = (id & 15) * 8;
      const size_t grow = (size_t)(lrow0 + rowl);
      const u32x2 ya = *(const u32x2*)(Ys + rowl * 132 + c8), yb = *(const u32x2*)(Ys + rowl * 132 + c8 + 4);
      const u32x4 s8 = *(const u32x4*)(p.Z + grow * ZC + 2048 + hh * 128 + c8);
      u32x4 y;
      y.x = pk2(bflo(ya.x) * bflo(s8.x), bfhi(ya.x) * bfhi(s8.x));
      y.y = pk2(bflo(ya.y) * bflo(s8.y), bfhi(ya.y) * bfhi(s8.y));
      y.z = pk2(bflo(yb.x) * bflo(s8.z), bfhi(yb.x) * bfhi(s8.z));
      y.w = pk2(bflo(yb.y) * bflo(s8.w), bfhi(yb.y) * bfhi(s8.w));
      *(u32x4*)(p.Y + grow * YC + 512 + hh * 128 + c8) = y;
    }
  }
}

template <int MODE, int TEAM>
DI void c_tile(PP pp, int l, int lrow0, int hh, const KVSeg& s0, const KVSeg& s1, int na_qrow0, int na_R0, char* lds) {
  const int tt = tidx() & (TEAM - 1), lane = tt & 63, wq = tt >> 6, h = lane >> 5, r = lane & 31;
  const int row = lrow0 + wq * 32 + r;
  float* relb = (float*)(lds + 36864);
  if (MODE == 1) {
    __syncthreads();
    {
      const float* rbp = p.na_rel_bias + (size_t)(l * 8 + hh) * 465;
      const int i0 = tt, i1 = tt + TEAM;
      const float v0 = (i0 < 465) ? rbp[i0] : 0.f, v1 = (i1 < 465) ? rbp[i1] : 0.f;
      if (i0 < 465) relb[48 + i0] = v0 * LOG2E;
      if (i1 < 465) relb[48 + i1] = v1 * LOG2E;
    }
  }
  f32x16 O[2];
  float ls;
  attn_pass<2, MODE, TEAM>(p.Z + (size_t)row * ZC + 2560 + hh * 64, s0, s1, O, ls, na_qrow0 + (wq >> 1), (wq & 1) * 32 + r, na_R0, relb, lds);
  const float inv = 1.f / ls;
  __syncthreads();
  bf16_t* Ys = (bf16_t*)lds;
#pragma unroll
  for (int dt = 0; dt < 2; ++dt)
#pragma unroll
    for (int gq = 0; gq < 4; ++gq) {
      const int dv0 = dt * 32 + 8 * gq + 4 * h;
      u32x2 w = {pk2(O[dt][4 * gq + 0] * inv, O[dt][4 * gq + 1] * inv), pk2(O[dt][4 * gq + 2] * inv, O[dt][4 * gq + 3] * inv)};
      *(u32x2*)(Ys + (wq * 32 + r) * 68 + dv0) = w;
    }
  __syncthreads();
#pragma unroll
  for (int i = 0; i < 4; ++i) {
    const int id = tt + TEAM * i, rowl = id >> 3, c8 = (id & 7) * 8;
    const size_t grow = (size_t)(lrow0 + rowl);
    const u32x2 ya = *(const u32x2*)(Ys + rowl * 68 + c8), yb = *(const u32x2*)(Ys + rowl * 68 + c8 + 4);
    const u32x4 s8 = *(const u32x4*)(p.Z + grow * ZC + 3584 + hh * 64 + c8);
    u32x4 y;
    y.x = pk2(bflo(ya.x) * bflo(s8.x), bfhi(ya.x) * bfhi(s8.x));
    y.y = pk2(bflo(ya.y) * bflo(s8.y), bfhi(ya.y) * bfhi(s8.y));
    y.z = pk2(bflo(yb.x) * bflo(s8.z), bfhi(yb.x) * bfhi(s8.z));
    y.w = pk2(bflo(yb.y) * bflo(s8.w), bfhi(yb.y) * bfhi(s8.w));
    *(u32x4*)(p.Y + grow * YC + 1024 + hh * 64 + c8) = y;
  }
}

DI void a_tile(PP pp, int l, int ch, int g, char* lds) {
  const int tid = tidx() & 255, lane = tid & 63, wid = tid >> 6, h = lane >> 5, r = lane & 31;
  float* red = (float*)lds;
  float* stat = (float*)(lds + 16384);
  bf16_t* Bs = (bf16_t*)(lds + 17408);
  const bf16_t* Va = p.VTa + (size_t)ch * 512 * 128;
  __syncthreads();
  {
    const int q8 = (tid & 15) * 8, cgp = tid >> 4;
    float s[8], q[8];
#pragma unroll
    for (int j = 0; j < 8; ++j) { s[j] = 0.f; q[j] = 0.f; }
#pragma unroll
    for (int c0 = cgp * 32; c0 < cgp * 32 + 32; c0 += 16) {
      u32x4 w[16];
#pragma unroll
      for (int k = 0; k < 16; ++k) w[k] = *(const u32x4*)(Va + (size_t)(c0 + k) * 128 + q8);
#pragma unroll
      for (int k = 0; k < 16; ++k) {
        const float f[8] = {bflo(w[k].x), bfhi(w[k].x), bflo(w[k].y), bfhi(w[k].y), bflo(w[k].z), bfhi(w[k].z), bflo(w[k].w), bfhi(w[k].w)};
#pragma unroll
        for (int j = 0; j < 8; ++j) { s[j] += f[j]; q[j] += f[j] * f[j]; }
      }
    }
#pragma unroll
    for (int j = 0; j < 8; ++j) { red[(cgp * 128 + q8 + j) * 2] = s[j]; red[(cgp * 128 + q8 + j) * 2 + 1] = q[j]; }
  }
  __syncthreads();
  if (tid < 128) {
    float s = 0.f, q = 0.f;
#pragma unroll
    for (int k = 0; k < 16; ++k) { s += red[(k * 128 + tid) * 2]; q += red[(k * 128 + tid) * 2 + 1]; }
    const float mu = s * (1.f / 512.f), var = fmaxf(q * (1.f / 512.f) - mu * mu, 0.f);
    stat[tid * 2] = mu; stat[tid * 2 + 1] = rsqrtf(var + EPS);
  }
  __syncthreads();
  {
    u32x4 w[8];
#pragma unroll
    for (int i = 0; i < 8; ++i) { const int id = tid + 256 * i, c = id >> 4, qc = id & 15; w[i] = *(const u32x4*)(Va + (size_t)(g * 128 + c) * 128 + qc * 8); }
#pragma unroll
    for (int i = 0; i < 8; ++i) {
      const int id = tid + 256 * i, c = id >> 4, qc = id & 15;
      const float gam = p.sg_norm_g[l * 512 + g * 128 + c], bet = p.sg_norm_b[l * 512 + g * 128 + c];
      const float f[8] = {bflo(w[i].x), bfhi(w[i].x), bflo(w[i].y), bfhi(w[i].y), bflo(w[i].z), bfhi(w[i].z), bflo(w[i].w), bfhi(w[i].w)};
      float o[8];
#pragma unroll
      for (int j = 0; j < 8; ++j) { const int q = qc * 8 + j; o[j] = (f[j] - stat[q * 2]) * stat[q * 2 + 1] * gam + bet; }
      u32x4 ow = {pk2(o[0], o[1]), pk2(o[2], o[3]), pk2(o[4], o[5]), pk2(o[6], o[7])};
      *(u32x4*)(Bs + c * 136 + qc * 8) = ow;
    }
  }
  __syncthreads();
  f32x16 acc[4];
#pragma unroll
  for (int ct = 0; ct < 4; ++ct)
#pragma unroll
    for (int i = 0; i < 16; ++i) acc[ct][i] = 0.f;
  const bf16_t* W = p.Wsp + (size_t)(l * 4 + g) * 16384 + (size_t)(wid * 32 + r) * 128;
#pragma unroll
  for (int s = 0; s < 8; ++s) {
    const bf16x8 wf = *(const bf16x8*)(W + s * 16 + h * 8);
#pragma unroll
    for (int ct = 0; ct < 4; ++ct) {
      const bf16x8 vf = *(const bf16x8*)(Bs + (ct * 32 + r) * 136 + s * 16 + h * 8);
      acc[ct] = MFMA(vf, wf, acc[ct]);
    }
  }
  const int prw = wid * 32 + r;
  const float bsp = p.b_spatial[(l * 4 + g) * 128 + prw];
  __syncthreads();
  bf16_t* Ss = Bs;
#pragma unroll
  for (int ct = 0; ct < 4; ++ct)
#pragma unroll
    for (int gq = 0; gq < 4; ++gq) {
      u32x2 w = {pk2(acc[ct][4 * gq + 0] + bsp, acc[ct][4 * gq + 1] + bsp), pk2(acc[ct][4 * gq + 2] + bsp, acc[ct][4 * gq + 3] + bsp)};
      *(u32x2*)(Ss + prw * 132 + ct * 32 + 8 * gq + 4 * h) = w;
    }
  __syncthreads();
#pragma unroll
  for (int i = 0; i < 8; ++i) {
    const int id = tid + 256 * i, rowl = id >> 4, c8 = (id & 15) * 8;
    const size_t row = (size_t)ch * 128 + rowl;
    const u32x2 sa = *(const u32x2*)(Ss + rowl * 132 + c8), sb = *(const u32x2*)(Ss + rowl * 132 + c8 + 4);
    const u32x4 u8 = *(const u32x4*)(p.Z + row * ZC + g * 128 + c8), s8 = *(const u32x4*)(p.Z + row * ZC + 512 + g * 128 + c8);
    u32x4 y;
    y.x = pk2(bflo(u8.x) * bflo(sa.x) * bflo(s8.x), bfhi(u8.x) * bfhi(sa.x) * bfhi(s8.x));
    y.y = pk2(bflo(u8.y) * bflo(sa.y) * bflo(s8.y), bfhi(u8.y) * bfhi(sa.y) * bfhi(s8.y));
    y.z = pk2(bflo(u8.z) * bflo(sb.x) * bflo(s8.z), bfhi(u8.z) * bfhi(sb.x) * bfhi(s8.z));
    y.w = pk2(bflo(u8.w) * bflo(sb.y) * bflo(s8.w), bfhi(u8.w) * bfhi(sb.y) * bfhi(s8.w));
    *(u32x4*)(p.Y + row * YC + g * 128 + c8) = y;
  }
}

DI void phase_mix(PP pp0, int l, int g, char* lds, int mask = 31) {
  const int lat0 = g == 0 ? NCTX : 0;
  if (mask & 1) {
    PP pp = get_params();
#pragma unroll 1
    for (int u0 = blockIdx.x; u0 < 512; u0 += gridDim.x) {
      const int u = swz(u0, 512);
      const int lb = u >> 7, hh = (u >> 5) & 3, qb = u & 31, b = 4 * g + lb;
      const int krow0 = lat0 + lb * 4096;
      diff_tile(pp, l, krow0 + qb * 128, krow0, 64, hh, p.VTbL + (size_t)(lb * 4 + hh) * 128 * 4096, 4096,
                p.cdk + (size_t)b * 262144, p.cdvT + (size_t)(b * 4 + hh) * 65536, lds);
    }
  }
  if (mask & 2) {
    PP pp = get_params();
    const int team = tidx() >> 8;
#pragma unroll 1
    for (int u0 = blockIdx.x; u0 < 512; u0 += gridDim.x) {
      const int v = 2 * swz(u0, 512) + team;
      const int lb = v >> 8, hh = (v >> 5) & 7, pr = v & 31, b = 4 * g + lb;
      const int krow0 = lat0 + lb * 4096;
      int R0 = clampi(2 * pr - 4, 0, 56); if (R0 > 55) R0 = 55;
      KVSeg s0, s1;
      s0.K = p.cnk + (size_t)(b * 8 + hh) * 32768; s0.ldk = 64; s0.VT = p.cnvT + (size_t)(b * 8 + hh) * 32768; s0.ldvt = 512; s0.nblk = 8;
      s1.K = p.Z + (size_t)(krow0 + R0 * 64) * ZC + 3072 + hh * 64; s1.ldk = ZC; s1.VT = p.VTcL + (size_t)(lb * 8 + hh) * 64 * 4096 + R0 * 64; s1.ldvt = 4096; s1.nblk = 9;
      c_tile<1, 256>(pp, l, krow0 + pr * 128, hh, s0, s1, 2 * pr, R0, lds + team * TEAM_LDS);
    }
  }
  if (g == 0 && (mask & 4)) {
    PP pp = get_params();
#pragma unroll 1
    for (int v = blockIdx.x; v < 128; v += gridDim.x) {
      const int b = v >> 3, hh = (v >> 1) & 3, qb = v & 1;
      diff_tile(pp, l, b * 256 + qb * 128, b * 256, 4, hh, p.VTbC + (size_t)(b * 4 + hh) * 128 * 256, 256, nullptr, nullptr, lds);
    }
  }
  if (g == 0 && (mask & 8)) {
    PP pp = get_params();
#pragma unroll 1
    for (int v = blockIdx.x; v < 128; v += gridDim.x) {
      const int b = v >> 3, hh = v & 7;
      KVSeg s0, s1;
      s0.K = p.Z + (size_t)(b * 256) * ZC + 3072 + hh * 64; s0.ldk = ZC; s0.VT = p.VTcC + (size_t)(b * 8 + hh) * 64 * 256; s0.ldvt = 256; s0.nblk = 4;
      s1 = s0; s1.nblk = 0;
      c_tile<0, 512>(pp, l, b * 256, hh, s0, s1, 0, 0, lds);
    }
  }
  if (mask & 16) {
    PP pp = get_params();
    const int team = tidx() >> 8;
    const int nA2 = g_nt(g) / 64;
#pragma unroll 1
    for (int v = blockIdx.x; v < nA2; v += gridDim.x) { const int t2 = 2 * v + team; a_tile(pp, l, t2 >> 2, t2 & 3, lds + team * TEAM_LDS); }
  }
}

DI void phase_merge(PP pp, int l, int g, char* lds) {
  const int ntm = g_nt(g) / 256, ntn = 8, ntiles = ntm * ntn;
  const int lane = tidx() & 63, wid = tidx() >> 6, wr = wid >> 2, wc = wid & 3, fr = lane & 15, fq = lane >> 4;
  bool pre = false;
#pragma unroll 1
  for (int u = blockIdx.x; u < ntiles; u += gridDim.x) {
    int tm, tn; tile_order(swz(u, ntiles), ntm, ntn, tm, tn);
    const int row0 = tm * 256, col0 = tn * 128;
    const bf16_t* Hrow = p.H + (size_t)(g_t0(g) + row0) * D;
    f32x4 macc[8][2]; zero_acc<2>(macc);
#pragma unroll 1
    for (int i = 0; i < 3; ++i) {
      unsigned gp[8][2][2];
      const bf16_t* Wb = (i == 0 ? p.WaT : i == 1 ? p.WbT : p.WcT) + ((size_t)l * 1024 + col0) * 512;
      {
        f32x4 ga[8][2]; zero_acc<2>(ga);
        gemm512<2, 3>(Hrow, D, p.WmgT + ((size_t)l * 3072 + i * 1024 + col0) * D, D, D, ga, lds, pre);
        gemm_pre<2, 3>(p.Y + (size_t)row0 * YC + i * 512, YC, Wb, 512, lds);
#pragma unroll
        for (int n = 0; n < 2; ++n) {
          const float bg = p.b_mgate[l * 3072 + i * 1024 + col0 + wc * 32 + n * 16 + fr];
#pragma unroll
          for (int m = 0; m < 8; ++m) {
            gp[m][n][0] = pk2(sigmoidf(ga[m][n][0] + bg), sigmoidf(ga[m][n][1] + bg));
            gp[m][n][1] = pk2(sigmoidf(ga[m][n][2] + bg), sigmoidf(ga[m][n][3] + bg));
          }
        }
      }
      f32x4 ya[8][2]; zero_acc<2>(ya);
      gemm512<2, 3>(p.Y + (size_t)row0 * YC + i * 512, YC, Wb, 512, 512, ya, lds, true);
      pre = false;
      if (i < 2) {
        gemm_pre<2, 3>(Hrow, D, p.WmgT + ((size_t)l * 3072 + (i + 1) * 1024 + col0) * D, D, lds);
        pre = true;
      } else if (u + (int)gridDim.x < ntiles) {
        int tm2, tn2; tile_order(swz(u + gridDim.x, ntiles), ntm, ntn, tm2, tn2);
        gemm_pre<2, 3>(p.H + (size_t)(g_t0(g) + tm2 * 256) * D, D, p.WmgT + ((size_t)l * 3072 + tn2 * 128) * D, D, lds);
        pre = true;
      }
#pragma unroll
      for (int m = 0; m < 8; ++m)
#pragma unroll
        for (int n = 0; n < 2; ++n) {
          macc[m][n][0] += bflo(gp[m][n][0]) * ya[m][n][0]; macc[m][n][1] += bfhi(gp[m][n][0]) * ya[m][n][1];
          macc[m][n][2] += bflo(gp[m][n][1]) * ya[m][n][2]; macc[m][n][3] += bfhi(gp[m][n][1]) * ya[m][n][3];
        }
    }
    {
      const int t2 = tidx(), lane = t2 & 63, wid = t2 >> 6, wr = wid >> 2, wc = wid & 3, fr = lane & 15, fq = lane >> 4;
      bf16_t* st = (bf16_t*)(lds + 98304 + wid * 5120);
      bf16_t* mrow = p.Z + (size_t)(row0 + wr * 128) * D + col0 + wc * 32;
#pragma unroll
      for (int half = 0; half < 2; ++half) {
#pragma unroll
        for (int mm = 0; mm < 4; ++mm)
#pragma unroll
          for (int n = 0; n < 2; ++n)
#pragma unroll
            for (int jj = 0; jj < 4; ++jj) st[(mm * 16 + fq * 4 + jj) * 40 + n * 16 + fr] = f2bf(macc[half * 4 + mm][n][jj]);
        asm volatile("s_waitcnt lgkmcnt(0)" ::: "memory");
#pragma unroll
        for (int i = 0; i < 4; ++i) {
          const int id = lane + 64 * i, rowl = id >> 2, ch = id & 3;
          const u32x4 w = *(const u32x4*)(st + rowl * 40 + ch * 8);
          *(u32x4*)(mrow + (size_t)(half * 64 + rowl) * D + ch * 8) = w;
        }
        asm volatile("s_waitcnt lgkmcnt(0)" ::: "memory");
      }
    }
  }
}

DI void phase_out(PP pp, int l, int g, char* lds) {
  const int ntm = g_nt(g) / 256, ntn = 8, ntiles = ntm * ntn;
  const int lane = tidx() & 63, wid = tidx() >> 6, wr = wid >> 2, wc = wid & 3, fr = lane & 15, fq = lane >> 4;
  bool pre = false;
#pragma unroll 1
  for (int u = blockIdx.x; u < ntiles; u += gridDim.x) {
    int tm, tn; tile_order(swz(u, ntiles), ntm, ntn, tm, tn);
    const int row0 = tm * 256, col0 = tn * 128;
    f32x4 acc[8][2]; zero_acc<2>(acc);
    gemm512<2, 3>(p.Z + (size_t)row0 * D, D, p.WoT + ((size_t)l * 1024 + col0) * D, D, D, acc, lds, pre);
    pre = false;
    if (u + (int)gridDim.x < ntiles) {
      int tm2, tn2; tile_order(swz(u + gridDim.x, ntiles), ntm, ntn, tm2, tn2);
      gemm_pre<2, 3>(p.Z + (size_t)(tm2 * 256) * D, D, p.WoT + ((size_t)l * 1024 + tn2 * 128) * D, D, lds);
      pre = true;
    }
    const int tk0 = g_t0(g) + row0 + wr * 128;
    const int cid = tk0 < NCTX ? 0 : 1 + ((tk0 - NCTX) >> 12);
    const float* xin0 = (l == 0) ? (tk0 < NCTX ? p.x_prompt + (size_t)tk0 * D : p.x_sample + (size_t)(tk0 - NCTX) * D) : p.out + (size_t)tk0 * D;
    float* xo0 = p.out + (size_t)tk0 * D;
    float* st = (float*)(lds + 98304 + wid * 4608);
    const float gate0 = p.mods[(size_t)(l * 9 + cid) * 3072 + 2048 + col0 + wc * 32 + fr];
    const float gate1 = p.mods[(size_t)(l * 9 + cid) * 3072 + 2048 + col0 + wc * 32 + 16 + fr];
#pragma unroll
    for (int q = 0; q < 4; ++q) {
#pragma unroll
      for (int mm = 0; mm < 2; ++mm)
#pragma unroll
        for (int jj = 0; jj < 4; ++jj) {
          st[(mm * 16 + fq * 4 + jj) * 36 + fr] = gate0 * acc[2 * q + mm][0][jj];
          st[(mm * 16 + fq * 4 + jj) * 36 + 16 + fr] = gate1 * acc[2 * q + mm][1][jj];
        }
      asm volatile("s_waitcnt lgkmcnt(0)" ::: "memory");
#pragma unroll
      for (int i = 0; i < 4; ++i) {
        const int id = lane + 64 * i, rowl = id >> 3, ch = id & 7;
        const f32x4 v = *(const f32x4*)(st + rowl * 36 + ch * 4);
        const size_t off = (size_t)(q * 32 + rowl) * D + col0 + wc * 32 + ch * 4;
        const f32x4 x4 = *(const f32x4*)(xin0 + off);
        *(f32x4*)(xo0 + off) = ALPHA * x4 + v;
      }
      asm volatile("s_waitcnt lgkmcnt(0)" ::: "memory");
    }
  }
}

#undef p
__global__ void __launch_bounds__(512) fwd_kernel(Params p_arg) {
  __shared__ __attribute__((aligned(1024))) char smem[SMEM_BYTES];
  cg::grid_group grid = cg::this_grid();
  const int ph_lo = get_params()->phase_lo, ph_hi = get_params()->phase_hi;
  unsigned nbar = 0;
#pragma unroll 1
  for (int ph = ph_lo; ph < ph_hi; ++ph) {
    PP pp = get_params();
    bool sync_after = true;
    if (ph == 0) {
      if (blockIdx.x == 0 && __builtin_amdgcn_workitem_id_x() == 0) __hip_atomic_store(pp->bar, 0u, __ATOMIC_RELAXED, __HIP_MEMORY_SCOPE_AGENT);
      if (ONLY < 0 || ONLY == 0) phase0(pp, smem);
    }
    else if (ph == 1) { if (ONLY < 0 || ONLY == 1) ln_phase(pp, 0, 0, NTOK, 0); }
    else {
      const int q = ph - 2, lg = q / 5, sub = q % 5, l = lg >> 1, g = lg & 1;
      if (sub == 0) { if (ONLY < 0 || ONLY == 2) phase_in(pp, l, g, smem); }
      else if (sub == 1) { if (ONLY < 0 || ONLY == 3) phase_mix(pp, l, g, smem); }
      else if (sub == 2) { if (ONLY < 0 || ONLY == 4) phase_merge(pp, l, g, smem); }
      else if (sub == 3) { if (ONLY < 0 || ONLY == 5) phase_out(pp, l, g, smem); }
      else { if (ONLY < 0 || ONLY == 6) ln_phase(pp, l, g_t0(g), g_nt(g), 1); sync_after = false; }
    }
    if (sync_after && ph + 1 < ph_hi) {
      if (ph == 0) grid.sync();
      else { ++nbar; grid_bar(pp->bar, nbar * gridDim.x); }
    }
#if REPEAT_SUB >= 0
    if (ph >= 2 && (ph - 2) % 5 == REPEAT_SUB) {
      const int q = ph - 2, lg = q / 5, l = lg >> 1, g = lg & 1;
      if (REPEAT_SUB == 0) phase_in(pp, l, g, smem);
      else if (REPEAT_SUB == 1) phase_mix(pp, l, g, smem, MIXMASK);
      else if (REPEAT_SUB == 2) phase_merge(pp, l, g, smem);
      grid.sync();
    }
#endif
  }
}

static size_t align_up(size_t v) { return (v + 255) & ~(size_t)255; }

extern "C" void kernel_launch(void* const* d_in, const int* in_sizes, int n_in, void* d_out, int out_size, void* d_ws, size_t ws_size,
                              hipStream_t stream) {
  Params p{};
  const float** ip = (const float**)&p;
  for (int i = 0; i < 29; ++i) ip[i] = (const float*)d_in[i];
  p.out = (float*)d_out;
  char* w = (char*)d_ws;
  size_t off = 0;
  auto take = [&](size_t bytes) { char* r = w + off; off += align_up(bytes); return r; };
  p.WinT = (bf16_t*)take((size_t)4 * DIN * D * 2);
  p.WmgT = (bf16_t*)take((size_t)4 * 3072 * D * 2);
  p.WaT = (bf16_t*)take((size_t)4 * 1024 * 512 * 2);
  p.WbT = (bf16_t*)take((size_t)4 * 1024 * 512 * 2);
  p.WcT = (bf16_t*)take((size_t)4 * 1024 * 512 * 2);
  p.WoT = (bf16_t*)take((size_t)4 * 1024 * 1024 * 2);
  p.Wsp = (bf16_t*)take((size_t)4 * 4 * 128 * 128 * 2);
  p.cdk = (bf16_t*)take((size_t)8 * 262144 * 2);
  p.cdvT = (bf16_t*)take((size_t)8 * 262144 * 2);
  p.cnk = (bf16_t*)take((size_t)8 * 262144 * 2);
  p.cnvT = (bf16_t*)take((size_t)8 * 262144 * 2);
  p.H = (bf16_t*)take((size_t)NTOK * D * 2);
  p.Z = (bf16_t*)take((size_t)TG * ZC * 2);
  p.Y = (bf16_t*)take((size_t)TG * YC * 2);
  p.VTa = (bf16_t*)take((size_t)TG * 512 * 2);
  p.VTbL = (bf16_t*)take((size_t)4 * 4 * 128 * 4096 * 2);
  p.VTbC = (bf16_t*)take((size_t)16 * 4 * 128 * 256 * 2);
  p.VTcL = (bf16_t*)take((size_t)4 * 8 * 64 * 4096 * 2);
  p.VTcC = (bf16_t*)take((size_t)16 * 8 * 64 * 256 * 2);
  p.mods = (float*)take((size_t)4 * 9 * 3072 * 4);
  p.rope = (float*)take((size_t)64 * 16 * 2 * 4);
  p.lam = (float*)take(256);
  p.bar = (unsigned*)take(256);
  for (int l = 0; l < 4; ++l) p.lam_init[l] = (float)(0.8 - 0.6 * exp(-0.3 * (double)l));
  p.phase_lo = 0; p.phase_hi = 2 + 8 * 5;
  if (off > ws_size) { fprintf(stderr, "workspace too small: need %zu have %zu\n", off, ws_size); return; }

  static int grid_blocks = 0;
  if (!grid_blocks) {
    int dev = 0, cus = 0, per_cu = 0;
    (void)hipGetDevice(&dev);
    (void)hipDeviceGetAttribute(&cus, hipDeviceAttributeMultiprocessorCount, dev);
    (void)hipOccupancyMaxActiveBlocksPerMultiprocessor(&per_cu, fwd_kernel, NTHR, 0);
    if (per_cu < 1) per_cu = 1;
    if (per_cu > 1) per_cu = 1;
    grid_blocks = cus * per_cu;
  }
  void* args[] = {&p};
  hipError_t e = hipLaunchCooperativeKernel((void*)fwd_kernel, dim3(grid_blocks), dim3(NTHR), args, 0, stream);
  if (e != hipSuccess) fprintf(stderr, "cooperative launch failed: %s (grid %d)\n", hipGetErrorString(e), grid_blocks);
}
```
